# Optimizing an MI355X kernel written in HIP

```python
import math
import jax, jax.numpy as jnp
from jax import lax
import numpy as np

D_MODEL = 1024
BATCH = 4
SEQ = 8192
DEPTH = 2

CHUNK = 64
Q_BLOCK = 128
N_MIXERS = 2
N_ATTN_LAYERS = (DEPTH + 1) // 2
N_RET_LAYERS = DEPTH // 2

DA_HEADS = 8
DA_HEAD_DIM = D_MODEL // (2 * DA_HEADS)
DA_V_DIM = 2 * DA_HEAD_DIM
DA_QK_WIDTH = 2 * DA_HEADS * DA_HEAD_DIM
DA_V_WIDTH = DA_HEADS * DA_V_DIM
DA_IN_WIDTH = 2 * DA_QK_WIDTH + 2 * DA_V_WIDTH

RET_HEADS = 4
RET_QK_DIM = D_MODEL // RET_HEADS
RET_V_DIM = 2 * RET_QK_DIM
RET_QK_WIDTH = RET_HEADS * RET_QK_DIM
RET_V_WIDTH = RET_HEADS * RET_V_DIM
RET_IN_WIDTH = 2 * RET_QK_WIDTH + 2 * RET_V_WIDTH

NORM_EPS = 1e-6
HEAD_NORM_EPS = 1e-5

kernel_name = "hybrid_diffattn_retention_streaming_block"


def rms_norm(x, gain, eps=NORM_EPS):
    xf = x.astype(jnp.float32)
    y = xf * lax.rsqrt(jnp.mean(xf * xf, axis=-1, keepdims=True) + eps)
    return (y * gain.astype(jnp.float32)).astype(x.dtype)


def head_rms_norm(x, eps=HEAD_NORM_EPS):
    xf = x.astype(jnp.float32)
    return xf * lax.rsqrt(jnp.mean(xf * xf, axis=-1, keepdims=True) + eps)


def alibi_slopes(n_heads):
    return jnp.asarray([2.0 ** (-8.0 * (h + 1) / n_heads) for h in range(n_heads)], dtype=jnp.float32)


def retention_log_gammas(n_heads):
    gammas = 1.0 - 2.0 ** (-5.0 - jnp.arange(n_heads, dtype=jnp.float32))
    return jnp.log(gammas)


def diff_attention(h, w_in, w_out, lq1, lk1, lq2, lk2, subln_gain, lam_init):
    B, S, _ = h.shape
    f32 = jnp.float32
    proj = jnp.einsum("bsd,de->bse", h, w_in)
    q, k, v, g = jnp.split(proj, [DA_QK_WIDTH, 2 * DA_QK_WIDTH, 2 * DA_QK_WIDTH + DA_V_WIDTH], axis=-1)
    q = q.reshape(B, S, DA_HEADS, 2, DA_HEAD_DIM).astype(f32) * (DA_HEAD_DIM ** -0.5)
    k = k.reshape(B, S, DA_HEADS, 2, DA_HEAD_DIM).astype(f32)
    v = v.reshape(B, S, DA_HEADS, DA_V_DIM).astype(f32)
    lam = (jnp.exp(jnp.sum(lq1.astype(f32) * lk1.astype(f32)))
           - jnp.exp(jnp.sum(lq2.astype(f32) * lk2.astype(f32))) + lam_init)
    slopes = alibi_slopes(DA_HEADS)
    k_pos = jnp.arange(S)
    n_blocks = S // Q_BLOCK
    q_blocks = jnp.moveaxis(q.reshape(B, n_blocks, Q_BLOCK, DA_HEADS, 2, DA_HEAD_DIM), 1, 0)

    def attend(args):
        q_blk, blk = args
        q_pos = blk * Q_BLOCK + jnp.arange(Q_BLOCK)
        scores = jnp.einsum("bqhcd,bkhcd->bhcqk", q_blk, k)
        dist = jnp.abs(q_pos[:, None] - k_pos[None, :]).astype(f32)
        bias = -slopes[:, None, None, None] * dist
        allowed = (k_pos[None, :] // CHUNK) <= (q_pos[:, None] // CHUNK)
        scores = jnp.where(allowed, scores + bias, -jnp.inf)
        probs = jax.nn.softmax(scores, axis=-1)
        diff = probs[:, :, 0] - lam * probs[:, :, 1]
        return jnp.einsum("bhqk,bkhe->bqhe", diff, v)

    out = lax.map(attend, (q_blocks, jnp.arange(n_blocks)))
    out = jnp.moveaxis(out, 0, 1).reshape(B, S, DA_HEADS, DA_V_DIM)
    out = head_rms_norm(out) * subln_gain.astype(f32) * (1.0 - lam_init)
    y = jax.nn.silu(g.astype(f32)) * out.reshape(B, S, DA_V_WIDTH)
    return jnp.einsum("bse,ed->bsd", y.astype(h.dtype), w_out)


def retention(h, w_in, w_out):
    B, S, _ = h.shape
    f32 = jnp.float32
    n_chunks = S // CHUNK
    proj = jnp.einsum("bsd,de->bse", h, w_in)
    q, k, v, g = jnp.split(proj, [RET_QK_WIDTH, 2 * RET_QK_WIDTH, 2 * RET_QK_WIDTH + RET_V_WIDTH], axis=-1)
    q = q.reshape(B, n_chunks, CHUNK, RET_HEADS, RET_QK_DIM).astype(f32)
    k = k.reshape(B, n_chunks, CHUNK, RET_HEADS, RET_QK_DIM).astype(f32) * (RET_QK_DIM ** -0.5)
    v = v.reshape(B, n_chunks, CHUNK, RET_HEADS, RET_V_DIM).astype(f32)

    log_gamma = retention_log_gammas(RET_HEADS)
    idx = jnp.arange(CHUNK, dtype=f32)
    intra_decay = jnp.exp(log_gamma[:, None, None] * jnp.abs(idx[:, None] - idx[None, :]))
    query_decay = jnp.exp(idx[:, None] * log_gamma[None, :])
    key_decay = jnp.exp((CHUNK - idx)[:, None] * log_gamma[None, :])
    chunk_decay = jnp.exp(CHUNK * log_gamma)

    inner = jnp.einsum("bnihd,bnjhd->bnhij", q, k) * intra_decay
    inner_out = jnp.einsum("bnhij,bnjhe->bnihe", inner, v)

    def step(state, qkv):
        q_c, k_c, v_c = qkv
        cross = jnp.einsum("bihd,bhde->bihe", q_c * query_decay[None, :, :, None], state)
        state = (chunk_decay[None, :, None, None] * state
                 + jnp.einsum("bjhd,bjhe->bhde", k_c * key_decay[None, :, :, None], v_c))
        return state, cross

    state0 = jnp.zeros((B, RET_HEADS, RET_QK_DIM, RET_V_DIM), f32)
    _, cross = lax.scan(step, state0, (jnp.moveaxis(q, 1, 0), jnp.moveaxis(k, 1, 0), jnp.moveaxis(v, 1, 0)))
    out = inner_out + jnp.moveaxis(cross, 0, 1)
    out = head_rms_norm(out).reshape(B, S, RET_V_WIDTH)
    y = jax.nn.silu(g.astype(f32)) * out
    return jnp.einsum("bse,ed->bsd", y.astype(h.dtype), w_out)


def setup_inputs(seed: int = 0) -> dict:
    key = jax.random.key(seed)
    ks = jax.random.split(key, 16)
    D = D_MODEL
    nrm = jax.random.normal
    return {
        "x": nrm(ks[0], (BATCH, SEQ, D), jnp.float32),
        "c": nrm(ks[1], (BATCH, D), jnp.float32),
        "ada_w": nrm(ks[2], (DEPTH, D, 3 * D), jnp.float32) * (0.5 * D ** -0.5),
        "ada_b": nrm(ks[3], (DEPTH, 3 * D), jnp.float32) * 0.01,
        "pre_gain": 1.0 + 0.05 * nrm(ks[4], (DEPTH, D), jnp.float32),
        "post_gain": 1.0 + 0.05 * nrm(ks[5], (DEPTH, D), jnp.float32),
        "da_w_in": nrm(ks[6], (N_ATTN_LAYERS, D, DA_IN_WIDTH), jnp.float32) * D ** -0.5,
        "da_w_out": nrm(ks[7], (N_ATTN_LAYERS, DA_V_WIDTH, D), jnp.float32) * DA_V_WIDTH ** -0.5,
        "da_lambda_q1": 0.1 * nrm(ks[8], (N_ATTN_LAYERS, DA_HEAD_DIM), jnp.float32),
        "da_lambda_k1": 0.1 * nrm(ks[9], (N_ATTN_LAYERS, DA_HEAD_DIM), jnp.float32),
        "da_lambda_q2": 0.1 * nrm(ks[10], (N_ATTN_LAYERS, DA_HEAD_DIM), jnp.float32),
        "da_lambda_k2": 0.1 * nrm(ks[11], (N_ATTN_LAYERS, DA_HEAD_DIM), jnp.float32),
        "da_subln_gain": 1.0 + 0.05 * nrm(ks[12], (N_ATTN_LAYERS, DA_V_DIM), jnp.float32),
        "ret_w_in": nrm(ks[13], (N_RET_LAYERS, D, RET_IN_WIDTH), jnp.float32) * D ** -0.5,
        "ret_w_out": nrm(ks[14], (N_RET_LAYERS, RET_V_WIDTH, D), jnp.float32) * RET_V_WIDTH ** -0.5,
    }


def reference(x, c, ada_w, ada_b, pre_gain, post_gain, da_w_in, da_w_out, da_lambda_q1, da_lambda_k1,
              da_lambda_q2, da_lambda_k2, da_subln_gain, ret_w_in, ret_w_out):
    cond = jax.nn.silu(c)
    for layer in range(DEPTH):
        mod = jnp.einsum("bd,de->be", cond, ada_w[layer]) + ada_b[layer]
        shift, scale, gate = jnp.split(mod, 3, axis=-1)
        h = rms_norm(x, pre_gain[layer]) * (1.0 + scale[:, None, :]) + shift[:, None, :]
        j = layer // N_MIXERS
        if layer % N_MIXERS == 0:
            lam_init = 0.8 - 0.6 * math.exp(-0.3 * layer)
            y = diff_attention(h, da_w_in[j], da_w_out[j], da_lambda_q1[j], da_lambda_k1[j],
                               da_lambda_q2[j], da_lambda_k2[j], da_subln_gain[j], lam_init)
        else:
            y = retention(h, ret_w_in[j], ret_w_out[j])
        x = x + gate[:, None, :] * rms_norm(y, post_gain[layer])
    return x
```

```cpp
#include <hip/hip_runtime.h>
#include <hip/hip_cooperative_groups.h>
#include <cstdio>
#include <cstdint>
namespace cg = cooperative_groups;

typedef unsigned short bf16_t;
typedef short bf16x8 __attribute__((ext_vector_type(8)));
typedef short s16x4 __attribute__((ext_vector_type(4)));
typedef float f32x4 __attribute__((ext_vector_type(4)));
typedef float f32x16 __attribute__((ext_vector_type(16)));
typedef float f32x2 __attribute__((ext_vector_type(2)));
typedef __bf16 bf16x2_t __attribute__((ext_vector_type(2)));
typedef unsigned u32x2 __attribute__((ext_vector_type(2)));
typedef unsigned u32x4 __attribute__((ext_vector_type(4)));
#define DI __device__ __forceinline__
#define LDS3 __attribute__((address_space(3)))

constexpr int DM = 1024, NB = 4, SEQ = 8192, NTOK = NB * SEQ;
constexpr int NT = 512;
constexpr int LD0 = 4096, LD1 = 6144;
constexpr float LOG2E = 1.4426950408889634f;
constexpr float QSCALE = 0.125f * LOG2E;
constexpr int SMEM_BYTES = 149504;

struct Params {
    const float *x, *c, *ada_w, *ada_b, *pre_gain, *post_gain, *da_w_in, *da_w_out, *lq1, *lk1, *lq2, *lk2, *subln, *ret_w_in, *ret_w_out;
    float* out;
    bf16_t *Wt0in, *Wt0out, *Wt1in, *Wt1out, *H, *P;
    float* mod;
};

DI unsigned pk2(float a, float b) { f32x2 v = {a, b}; bf16x2_t r = __builtin_convertvector(v, bf16x2_t); return __builtin_bit_cast(unsigned, r); }
DI float bflo(unsigned u) { return __uint_as_float(u << 16); }
DI float bfhi(unsigned u) { return __uint_as_float(u & 0xffff0000u); }
DI float4 ldnt_f4(const float* p) { const f32x4 v = __builtin_nontemporal_load((const f32x4*)p); return make_float4(v[0], v[1], v[2], v[3]); }
DI void stnt_f4(float* p, const float4 v) { const f32x4 t = {v.x, v.y, v.z, v.w}; __builtin_nontemporal_store(t, (f32x4*)p); }
DI u32x4 ldnt_u4(const void* p) { return __builtin_nontemporal_load((const u32x4*)p); }
DI u32x2 ldnt_u2(const void* p) { return __builtin_nontemporal_load((const u32x2*)p); }
DI void stnt_u4(void* p, const u32x4 v) { __builtin_nontemporal_store(v, (u32x4*)p); }
DI void stnt_u2(void* p, const u32x2 v) { __builtin_nontemporal_store(v, (u32x2*)p); }
DI float wave_sum(float v) {
#pragma unroll
    for (int o = 32; o; o >>= 1) v += __shfl_xor(v, o);
    return v;
}
DI float silu_f(float x) { return x * __builtin_amdgcn_rcpf(1.f + __builtin_amdgcn_exp2f(-x * LOG2E)); }
DI int lane_id() { int l; asm volatile("v_mbcnt_lo_u32_b32 %0, -1, 0\n\tv_mbcnt_hi_u32_b32 %0, -1, %0" : "=v"(l)); return l; }
#define TIDX (wid * 64 + lane_id())
#define RET_ST(p) ((p).P + (size_t)NTOK * LD1)
#define RET_C01(p) ((p).H)
#define RET_C23(p) ((p).P + (size_t)NTOK * LD1 + 2097152)
DI bf16x8 cat4(s16x4 a, s16x4 b) { return __builtin_shufflevector(a, b, 0, 1, 2, 3, 4, 5, 6, 7); }
DI s16x4 tr_read(const char* p) { return __builtin_amdgcn_ds_read_tr16_b64_v4i16((LDS3 s16x4*)p); }

DI void transpose_tile(const float* __restrict__ W, int K, int N, bf16_t* __restrict__ Wt, int tk, int tn, char* smem, const int wid) {
    float* s = (float*)smem;
    const int tid = TIDX;
    const int r = tid >> 4, c4 = (tid & 15) * 4;
#pragma unroll
    for (int p = 0; p < 2; ++p) {
        const int k = r + 32 * p;
        const float4 v = *(const float4*)(W + (size_t)(tk * 64 + k) * N + tn * 64 + c4);
        s[k * 65 + c4 + 0] = v.x; s[k * 65 + c4 + 1] = v.y; s[k * 65 + c4 + 2] = v.z; s[k * 65 + c4 + 3] = v.w;
    }
    __syncthreads();
    const int n = tid >> 3, kc = (tid & 7) * 8;
    u32x4 o;
    o.x = pk2(s[(kc + 0) * 65 + n], s[(kc + 1) * 65 + n]);
    o.y = pk2(s[(kc + 2) * 65 + n], s[(kc + 3) * 65 + n]);
    o.z = pk2(s[(kc + 4) * 65 + n], s[(kc + 5) * 65 + n]);
    o.w = pk2(s[(kc + 6) * 65 + n], s[(kc + 7) * 65 + n]);
    *(u32x4*)(Wt + (size_t)(tn * 64 + n) * K + tk * 64 + kc) = o;
    __syncthreads();
}

DI void mod_item(const Params& p, int item, char* smem, const int wid) {
    float* cond = (float*)smem;
    float* red = (float*)(smem + 16384);
    const int tid = TIDX, w = wid, lane = tid & 63;
    const int l = item / 48, e0 = (item % 48) * 64;
#pragma unroll
    for (int i = 0; i < 8; ++i) { const int idx = tid + 512 * i; cond[idx] = silu_f(p.c[idx]); }
    __syncthreads();
    float a0 = 0.f, a1 = 0.f, a2 = 0.f, a3 = 0.f;
    const float* wp = p.ada_w + (size_t)l * 1024 * 3072 + e0 + lane;
#pragma unroll 32
    for (int d = w * 128; d < w * 128 + 128; ++d) {
        const float wv = wp[(size_t)d * 3072];
        a0 += cond[d] * wv; a1 += cond[1024 + d] * wv; a2 += cond[2048 + d] * wv; a3 += cond[3072 + d] * wv;
    }
    red[(w * 4 + 0) * 64 + lane] = a0; red[(w * 4 + 1) * 64 + lane] = a1; red[(w * 4 + 2) * 64 + lane] = a2; red[(w * 4 + 3) * 64 + lane] = a3;
    __syncthreads();
    if (tid < 256) {
        const int b = tid >> 6, e = tid & 63;
        float s = p.ada_b[l * 3072 + e0 + e];
#pragma unroll
        for (int ww = 0; ww < 8; ++ww) s += red[(ww * 4 + b) * 64 + e];
        p.mod[(l * 4 + b) * 3072 + e0 + e] = s;
    }
    asm volatile("s_waitcnt vmcnt(0)" ::: "memory");
    __syncthreads();
    if (tid == 0) {
        __builtin_amdgcn_fence(__ATOMIC_RELEASE, "agent");
        asm volatile("s_waitcnt vmcnt(0)" ::: "memory");
        __hip_atomic_fetch_add((unsigned*)(p.mod + 34880), 1u, __ATOMIC_RELAXED, __HIP_MEMORY_SCOPE_AGENT);
    }
}

DI void prep_phase(const Params& p, char* smem, const int wid) {
    const int G = gridDim.x;
    { const int t0 = TIDX; if (blockIdx.x == 0 && t0 < 8) ((unsigned*)(p.mod + 24576 + 8192))[t0 * 16] = 0u; if (blockIdx.x == 0 && t0 == 8) *(unsigned*)(p.mod + 34816) = 0u; }
    auto do_tile = [&](int t) __attribute__((always_inline)) {
        if (t < 1024) { transpose_tile(p.da_w_in, 1024, 4096, p.Wt0in, t & 15, t >> 4, smem, wid); return; }
        t -= 1024;
        if (t < 256) { transpose_tile(p.da_w_out, 1024, 1024, p.Wt0out, t & 15, t >> 4, smem, wid); return; }
        t -= 256;
        if (t < 1536) { transpose_tile(p.ret_w_in, 1024, 6144, p.Wt1in, t & 15, t >> 4, smem, wid); return; }
        t -= 1536;
        transpose_tile(p.ret_w_out, 2048, 1024, p.Wt1out, t & 31, t >> 5, smem, wid);
    };
    if (G == 256) {
        if (blockIdx.x < 96) { mod_item(p, blockIdx.x, smem, wid); for (int j = 0; j < 7; ++j) do_tile(blockIdx.x + 96 * j); }
        else for (int t = 672 + (int)blockIdx.x - 96; t < 3328; t += 160) do_tile(t);
    } else
    for (int it = blockIdx.x; it < 96 + 3328; it += G) {
        if (it < 96) mod_item(p, it, smem, wid); else do_tile(it - 96);
    }
    if (wid == 0 && lane_id() == 0) {
        unsigned* mf = (unsigned*)(p.mod + 34880);
        while (__hip_atomic_load(mf, __ATOMIC_RELAXED, __HIP_MEMORY_SCOPE_AGENT) < 96u) __builtin_amdgcn_s_sleep(2);
        __builtin_amdgcn_fence(__ATOMIC_ACQUIRE, "agent");
        asm volatile("s_waitcnt vmcnt(0)" ::: "memory");
    }
    __syncthreads();
}

DI void norm0_phase(const Params& p, const int wid) {
    const int w = wid, lane = lane_id();
    const int stride = gridDim.x * 8;
    for (int row0 = blockIdx.x * 8 + w; row0 < NTOK; row0 += 2 * stride) {
        float4 v[2][4];
        float ss[2] = {0.f, 0.f};
#pragma unroll
        for (int r = 0; r < 2; ++r) {
            const int row = row0 + r * stride < NTOK ? row0 + r * stride : row0;
            const float* xr = p.x + (size_t)row * DM;
#pragma unroll
            for (int i = 0; i < 4; ++i) v[r][i] = ldnt_f4(xr + i * 256 + lane * 4);
        }
#pragma unroll
        for (int r = 0; r < 2; ++r) {
#pragma unroll
            for (int i = 0; i < 4; ++i) ss[r] += v[r][i].x * v[r][i].x + v[r][i].y * v[r][i].y + v[r][i].z * v[r][i].z + v[r][i].w * v[r][i].w;
            ss[r] = wave_sum(ss[r]);
        }
#pragma unroll
        for (int r = 0; r < 2; ++r) {
            const int row = row0 + r * stride;
            if (row >= NTOK) break;
            const float rstd = rsqrtf(ss[r] * (1.f / DM) + 1e-6f);
            const float* md = p.mod + (size_t)(row / SEQ) * 3072;
#pragma unroll
            for (int i = 0; i < 4; ++i) {
                const int d = i * 256 + lane * 4;
                const float4 g = *(const float4*)(p.pre_gain + d), sh = *(const float4*)(md + d), sc = *(const float4*)(md + 1024 + d);
                u32x2 o;
                o.x = pk2(v[r][i].x * rstd * g.x * (1.f + sc.x) + sh.x, v[r][i].y * rstd * g.y * (1.f + sc.y) + sh.y);
                o.y = pk2(v[r][i].z * rstd * g.z * (1.f + sc.z) + sh.z, v[r][i].w * rstd * g.w * (1.f + sc.w) + sh.w);
                stnt_u2(p.H + (size_t)row * DM + d, o);
            }
        }
    }
}

template <int LAYER>
DI void post_phase(const Params& p, int ldp, const int wid) {
    const int w = wid, lane = lane_id();
    const int stride = gridDim.x * 8;
    for (int row0 = blockIdx.x * 8 + w; row0 < NTOK; row0 += 2 * stride) {
        float4 y[2][4], xv[2][4];
        float ss[2] = {0.f, 0.f};
#pragma unroll
        for (int r = 0; r < 2; ++r) {
            const int row = row0 + r * stride < NTOK ? row0 + r * stride : row0;
            const bf16_t* yr = p.P + (size_t)row * ldp;
            const float* xr = (LAYER == 0 ? p.x : p.out) + (size_t)row * DM;
#pragma unroll
            for (int i = 0; i < 4; ++i) {
                const u32x2 yb = ldnt_u2(yr + i * 256 + lane * 4);
                y[r][i].x = bflo(yb.x); y[r][i].y = bfhi(yb.x); y[r][i].z = bflo(yb.y); y[r][i].w = bfhi(yb.y);
                xv[r][i] = ldnt_f4(xr + i * 256 + lane * 4);
            }
        }
#pragma unroll
        for (int r = 0; r < 2; ++r) {
#pragma unroll
            for (int i = 0; i < 4; ++i) ss[r] += y[r][i].x * y[r][i].x + y[r][i].y * y[r][i].y + y[r][i].z * y[r][i].z + y[r][i].w * y[r][i].w;
            ss[r] = wave_sum(ss[r]);
        }
#pragma unroll
        for (int r = 0; r < 2; ++r) {
            const int row = row0 + r * stride;
            if (row >= NTOK) break;
            const float rstd = rsqrtf(ss[r] * (1.f / DM) + 1e-6f);
            const int b = row / SEQ;
            const float* md = p.mod + (size_t)(LAYER * 4 + b) * 3072;
            float ss1 = 0.f;
#pragma unroll
            for (int i = 0; i < 4; ++i) {
                const int d = i * 256 + lane * 4;
                const float4 g = *(const float4*)(p.post_gain + LAYER * DM + d), gt = *(const float4*)(md + 2048 + d);
                float4& x = xv[r][i]; const float4 yy = y[r][i];
                x.x += gt.x * yy.x * rstd * g.x; x.y += gt.y * yy.y * rstd * g.y; x.z += gt.z * yy.z * rstd * g.z; x.w += gt.w * yy.w * rstd * g.w;
                stnt_f4(p.out + (size_t)row * DM + d, x);
                ss1 += x.x * x.x + x.y * x.y + x.z * x.z + x.w * x.w;
            }
            if (LAYER == 0) {
                ss1 = wave_sum(ss1);
                const float r1 = rsqrtf(ss1 * (1.f / DM) + 1e-6f);
                const float* m1 = p.mod + (size_t)(4 + b) * 3072;
#pragma unroll
                for (int i = 0; i < 4; ++i) {
                    const int d = i * 256 + lane * 4;
                    const float4 g = *(const float4*)(p.pre_gain + DM + d), sh = *(const float4*)(m1 + d), sc = *(const float4*)(m1 + 1024 + d);
                    const float4 x = xv[r][i];
                    u32x2 o;
                    o.x = pk2(x.x * r1 * g.x * (1.f + sc.x) + sh.x, x.y * r1 * g.y * (1.f + sc.y) + sh.y);
                    o.y = pk2(x.z * r1 * g.z * (1.f + sc.z) + sh.z, x.w * r1 * g.w * (1.f + sc.w) + sh.w);
                    stnt_u2(p.H + (size_t)row * DM + d, o);
                }
            }
        }
    }
}

DI void gate1_phase(const Params& p, const int wid, const int half) {
    const int w = wid, lane = lane_id();
    for (int rr = blockIdx.x * 8 + w; rr < NTOK / 2; rr += gridDim.x * 8) {
        const int row = (rr >> 12) * SEQ + half * 4096 + (rr & 4095);
        bf16_t* pr = p.P + (size_t)row * LD1;
        const int spos = row & (SEQ - 1), bb = row >> 13;
        const bf16_t* cr = (bb < 2 ? RET_C01(p) : RET_C23(p)) + ((size_t)(bb & 1) * 4096 + (spos - 4096)) * 2048;
        u32x4 o[4], g[4];
        float rstd[4];
#pragma unroll
        for (int i = 0; i < 4; ++i) {
            o[i] = ldnt_u4(pr + 2048 + i * 512 + lane * 8);
            g[i] = ldnt_u4(pr + 4096 + i * 512 + lane * 8);
            if (spos >= 4096) {
                const u32x4 cv = ldnt_u4(cr + i * 512 + lane * 8);
#pragma unroll
                for (int j = 0; j < 4; ++j) o[i][j] = pk2(bflo(o[i][j]) + bflo(cv[j]), bfhi(o[i][j]) + bfhi(cv[j]));
            }
            float ss = 0.f;
#pragma unroll
            for (int j = 0; j < 4; ++j) { const float a = bflo(o[i][j]), b2 = bfhi(o[i][j]); ss += a * a + b2 * b2; }
            ss = wave_sum(ss);
            rstd[i] = rsqrtf(ss * (1.f / 512.f) + 1e-5f);
        }
#pragma unroll
        for (int i = 0; i < 4; ++i) {
            u32x4 y;
#pragma unroll
            for (int j = 0; j < 4; ++j)
                y[j] = pk2(silu_f(bflo(g[i][j])) * bflo(o[i][j]) * rstd[i], silu_f(bfhi(g[i][j])) * bfhi(o[i][j]) * rstd[i]);
            stnt_u4(pr + 4096 + i * 512 + lane * 8, y);
        }
    }
}

namespace pg8 {
constexpr int BM = 256, BK = 64, HALF = 128, HTB = HALF * BK * 2, NXCD = 8, WGM = 8;
DI int lds_byte(int r, int c) { const int st = (r >> 4) * 2 + (c >> 5), rr = r & 15, cc = c & 31, ob = rr * 64 + cc * 2; return st * 1024 + (ob ^ (((ob >> 9) & 1) << 5)); }
DI void stage_rc(int b, int& R, int& C) { const int st = b / 1024, sb = b % 1024, swz = sb ^ (((sb >> 9) & 1) << 5); R = (st >> 1) * 16 + swz / 64; C = (st & 1) * 32 + (swz % 64) / 2; }
DI int perm32(int rho) { const int n = rho >> 4, i = rho & 15; return 8 * (i >> 2) + 4 * n + (i & 3); }
struct Unit { int pm, pn; };
struct Gemm { const bf16_t* A; const bf16_t* Bt; int lda, N, K; };
struct StaticOrder {
    int nM, nN, nwg, G, c;
    DI void init(int M, int N, int G_, int c_) { nM = M / BM; nN = N / BM; nwg = nM * nN; G = G_; c = c_; }
    DI bool next(int i, Unit& u) const {
        const long L = (long)i * G + c; if (L >= nwg) return false;
        int wgid = (int)L; { const int q = nwg / NXCD, r = nwg % NXCD, xcd = wgid % NXCD, off = wgid / NXCD; wgid = (xcd < r ? xcd * (q + 1) : r * (q + 1) + (xcd - r) * q) + off; }
        const int nig = WGM * nN, gid = wgid / nig, fm = gid * WGM, gsz = (nM - fm) < WGM ? (nM - fm) : WGM;
        u.pm = fm + ((wgid % nig) % gsz); u.pn = (wgid % nig) / gsz; return true;
    }
    DI size_t a_off(const Unit& u, const Gemm& g) const { return (size_t)u.pm * (size_t)(2 * HALF) * g.lda * 2; }
    DI size_t b_off(const Unit& u, const Gemm& g) const { return (size_t)u.pn * (size_t)(2 * HALF) * g.K * 2; }
};
struct CorrOrder {
    int G, c;
    DI bool next(int i, Unit& u) const { const int idx = i * G + c; if (idx >= 512) return false; u.pm = idx >> 1; u.pn = idx & 1; return true; }
    DI size_t a_off(const Unit& u, const Gemm&) const { const int bh = u.pm >> 4, m = u.pm & 15, b = bh >> 2, h = bh & 3; return (((size_t)b * SEQ + 4096 + 256 * m) * LD1 + h * 256) * 2; }
    DI size_t b_off(const Unit& u, const Gemm&) const { const int bh = u.pm >> 4; return ((size_t)bh * 512 + 256 * u.pn) * 256 * 2; }
};
struct CorrEpi {
    bf16_t *C01, *C23;
    DI void operator()(const f32x4 (&acc)[2][2][4][2], const Unit& u, int wr, int wc, int fr, int fq) const {
        const int bh = u.pm >> 4, m = u.pm & 15, b = bh >> 2, h = bh & 3;
        const float lg = __log2f(1.f - exp2f(-5.f - (float)h));
        const size_t boff = (size_t)(b >> 1) * (size_t)(C23 - C01) + ((size_t)(b & 1) * 4096 + 256 * m) * 2048 + h * 512 + 256 * u.pn;
        bf16_t* cb = C01 + boff + (size_t)(wr * 64 + fr) * 2048 + wc * 32 + 8 * fq;
#pragma unroll
        for (int ai = 0; ai < 2; ++ai)
#pragma unroll
            for (int mm = 0; mm < 4; ++mm) {
                const int r = ai * HALF + wr * 64 + mm * 16 + fr;
                const float sc = __builtin_amdgcn_exp2f(lg * (float)(256 * m + r));
#pragma unroll
                for (int bj = 0; bj < 2; ++bj) {
                    const f32x4 v0 = acc[ai][bj][mm][0], v1 = acc[ai][bj][mm][1];
                    u32x4 wv;
                    wv.x = pk2(sc * v0[0], sc * v0[1]); wv.y = pk2(sc * v0[2], sc * v0[3]); wv.z = pk2(sc * v1[0], sc * v1[1]); wv.w = pk2(sc * v1[2], sc * v1[3]);
                    *(u32x4*)(cb + (ai * HALF + mm * 16) * 2048 + bj * HALF) = wv;
                }
                asm volatile("" ::: "memory");
            }
    }
};

template <int EPI> struct Epi {
    bf16_t* O; int ldo;
    float* kn; float* xch;
    DI void operator()(const f32x4 (&acc)[2][2][4][2], const Unit& u, int wr, int wc, int fr, int fq) const {
        const int n0 = u.pn * BM;
#pragma unroll
        for (int ai = 0; ai < 2; ++ai)
#pragma unroll
            for (int m = 0; m < 4; ++m) {
                const int tok = u.pm * BM + ai * HALF + wr * 64 + m * 16 + fr;
                float sc = 1.f;
                if (EPI == 0) { if (n0 < 1024) sc = QSCALE; }
                if (EPI == 1) {
                    if (n0 >= 1024 && n0 < 2048) {
                        const int hk = (n0 - 1024) >> 8;
                        const float lgk = __log2f(1.f - exp2f(-5.f - (float)hk));
                        sc = 0.0625f * exp2f(lgk * (float)(64 - (tok & 63)));
                    }
                }
#pragma unroll
                for (int bj = 0; bj < 2; ++bj) {
                    const int c0 = n0 + bj * HALF + wc * 32 + 8 * fq;
                    const f32x4 v0 = acc[ai][bj][m][0], v1 = acc[ai][bj][m][1];
                    {
                        u32x4 wv; wv.x = pk2(v0[0] * sc, v0[1] * sc); wv.y = pk2(v0[2] * sc, v0[3] * sc); wv.z = pk2(v1[0] * sc, v1[1] * sc); wv.w = pk2(v1[2] * sc, v1[3] * sc);
                        if (EPI == 0 && n0 >= 1024 && n0 < 2048) {
                            float sq = 0.f;
#pragma unroll
                            for (int j = 0; j < 4; ++j) { const float a = bflo(wv[j]), c2 = bfhi(wv[j]); sq += a * a + c2 * c2; }
                            sq += __shfl_xor(sq, 16); sq += __shfl_xor(sq, 32);
                            if (fq == 0) xch[(((wr * 4 + wc) * 2 + ai) * 4 + m) * 32 + fr * 2 + bj] = sq;
                        }
                        if (EPI == 0 && n0 >= 1024 && n0 < 3072) {
                            const int cc = c0 - 1024, r = cc >> 10, hd = (cc >> 7) & 7, wi = cc & 127;
                            bf16_t* kv = O + (size_t)NTOK * LD0;
                            *(u32x4*)(kv + (((size_t)(tok >> 13) * 8 + hd) * SEQ + (tok & (SEQ - 1))) * 256 + r * 128 + wi) = wv;
                        } else
                        if (EPI == 1 && n0 >= 4096) stnt_u4(O + (size_t)tok * ldo + c0, wv);
                        else *(u32x4*)(O + (size_t)tok * ldo + c0) = wv;
                    }
                }
            }
        if (EPI == 0 && n0 >= 1024 && n0 < 2048) {
            __syncthreads();
            const int lane = fr + 16 * fq;
            if ((wc & 1) == 0) {
#pragma unroll
                for (int ai = 0; ai < 2; ++ai)
#pragma unroll
                    for (int bj = 0; bj < 2; ++bj) {
                        float mx = 0.f;
#pragma unroll
                        for (int m = 0; m < 4; ++m) {
                            const int o = (ai * 4 + m) * 32 + fr * 2 + bj;
                            mx = fmaxf(mx, xch[(wr * 4 + wc) * 256 + o] + xch[(wr * 4 + wc + 1) * 256 + o]);
                        }
                        mx = fmaxf(mx, __shfl_xor(mx, 1)); mx = fmaxf(mx, __shfl_xor(mx, 2)); mx = fmaxf(mx, __shfl_xor(mx, 4)); mx = fmaxf(mx, __shfl_xor(mx, 8));
                        if (lane == 0) {
                            const int tok0 = u.pm * BM + ai * HALF + wr * 64, b = tok0 >> 13, jt = (tok0 & (SEQ - 1)) >> 6;
                            const int cb = 2 * bj + (wc >> 1), h = ((n0 - 1024) >> 7) + (cb >> 1), c = cb & 1;
                            kn[((b * 8 + h) * 2 + c) * 128 + jt] = mx;
                        }
                    }
            }
            __syncthreads();
        }
    }
};

template <class EpiT, class SchedT>
DI void gemm_phase(LDS3 unsigned char* lds, const Gemm g, const SchedT& S, const EpiT& E, const int wid) {
    const int tid = TIDX, lane = tid & 63, wr = wid >> 2, wc = wid & 3, fr = lane & 15, fq = lane >> 4;
    const int K = g.K, nt = K / BK, lda = g.lda;
    unsigned voffA[2], voffB[2];
#pragma unroll
    for (int i = 0; i < 2; ++i) { int R, C; stage_rc(tid * 16 + i * 8192, R, C); const int Rb = (R & ~31) + perm32(R & 31);
        voffA[i] = (unsigned)(R * lda + C) * 2u; voffB[i] = (unsigned)(Rb * K + C) * 2u; }
    const size_t kstep = (size_t)(BK * 2);
    const size_t hstepA = (size_t)HALF * lda * 2, hstepB = (size_t)HALF * K * 2;
        const unsigned ldsw = (unsigned)wid * 1024u;
    const int aoff = lds_byte(wr * 64 + fr, fq * 8), boff = lds_byte(wc * 32 + fr, fq * 8);
#define PG8_SA(b, h) (((b) * 2 + (h)) * HTB)
#define PG8_SB(b, h) ((4 + (b) * 2 + (h)) * HTB)
#define PG8_STAGE(bufoff, gbase, voff) do { _Pragma("unroll") for (int _i = 0; _i < 2; ++_i) \
        __builtin_amdgcn_global_load_lds((const unsigned*)((const char*)(gbase) + (voff)[_i]), (LDS3 unsigned*)(lds + (bufoff) + ldsw + _i * 8192), 16, 0, 0); } while (0)
#define PG8_LDA(dst, b, h) do { _Pragma("unroll") for (int m = 0; m < 4; ++m) _Pragma("unroll") for (int k = 0; k < 2; ++k) dst[m][k] = *(const LDS3 bf16x8*)(lds + PG8_SA(b, h) + aoff + m * 2048 + k * 1024); } while (0)
#define PG8_LDB(dst, b, h) do { _Pragma("unroll") for (int n = 0; n < 2; ++n) _Pragma("unroll") for (int k = 0; k < 2; ++k) dst[n][k] = *(const LDS3 bf16x8*)(lds + PG8_SB(b, h) + boff + n * 2048 + k * 1024); } while (0)
#define PG8_MMA(ai, bj, At, Bt) do { __builtin_amdgcn_s_setprio(1); _Pragma("unroll") for (int m = 0; m < 4; ++m) _Pragma("unroll") for (int n = 0; n < 2; ++n) _Pragma("unroll") for (int k = 0; k < 2; ++k) \
        acc[ai][bj][m][n] = __builtin_amdgcn_mfma_f32_16x16x32_bf16(Bt[n][k], At[m][k], acc[ai][bj][m][n], 0, 0, 0); __builtin_amdgcn_s_setprio(0); } while (0)
#define PG8_WAIT_V(n) asm volatile("s_waitcnt vmcnt(" #n ")" ::: "memory")
#define PG8_WAIT_L(n) asm volatile("s_waitcnt lgkmcnt(" #n ")" ::: "memory")
#define PG8_BAR __builtin_amdgcn_s_barrier()
#define PG8_SCHED __builtin_amdgcn_sched_barrier(0)
    Unit cur, nxt; int ui = 0;
    if (!S.next(0, cur)) return;
    f32x4 acc[2][2][4][2];
#pragma unroll
    for (int a = 0; a < 2; ++a)
#pragma unroll
        for (int b = 0; b < 2; ++b)
#pragma unroll
            for (int m = 0; m < 4; ++m)
#pragma unroll
                for (int n = 0; n < 2; ++n) acc[a][b][m][n] = (f32x4){0.f, 0.f, 0.f, 0.f};
    bf16x8 At[4][2], B0[2][2], B1[2][2];
    const char* cA = (const char*)g.A + S.a_off(cur, g); const char* cB = (const char*)g.Bt + S.b_off(cur, g);
    PG8_STAGE(PG8_SB(0, 0), cB, voffB); PG8_STAGE(PG8_SB(0, 1), cB + hstepB, voffB); PG8_STAGE(PG8_SA(0, 0), cA, voffA); PG8_STAGE(PG8_SA(0, 1), cA + hstepA, voffA);
    if (wr == 1) PG8_BAR;
    PG8_WAIT_V(2); PG8_BAR;
    PG8_STAGE(PG8_SB(1, 0), cB + kstep, voffB); PG8_STAGE(PG8_SA(1, 0), cA + kstep, voffA); PG8_STAGE(PG8_SB(1, 1), cB + hstepB + kstep, voffB);
    PG8_WAIT_V(6); PG8_BAR;
    for (;;) {
        const bool has_next = S.next(ui + 1, nxt);
        const char* nA = has_next ? (const char*)g.A + S.a_off(nxt, g) : cA; const char* nB = has_next ? (const char*)g.Bt + S.b_off(nxt, g) : cB;
        for (int t = 0; t < nt; t += 2) {
            const bool last = (t == nt - 2);
            const char* a1 = cA + (size_t)(t + 1) * kstep;
            const char* a2 = last ? nA : cA + (size_t)(t + 2) * kstep; const char* b2 = last ? nB : cB + (size_t)(t + 2) * kstep;
            const char* a3 = a2 + kstep; const char* b3 = b2 + kstep;
            PG8_LDB(B0, 0, 0); PG8_LDB(B1, 0, 1); PG8_SCHED; PG8_LDA(At, 0, 0); PG8_STAGE(PG8_SA(1, 1), a1 + hstepA, voffA);
            PG8_WAIT_V(8); PG8_WAIT_L(0); PG8_BAR; PG8_MMA(0, 0, At, B0); PG8_MMA(0, 1, At, B1); PG8_BAR; PG8_SCHED;
            PG8_LDA(At, 0, 1); PG8_STAGE(PG8_SB(0, 0), b2, voffB); PG8_STAGE(PG8_SB(0, 1), b2 + hstepB, voffB); PG8_STAGE(PG8_SA(0, 0), a2, voffA);
            PG8_WAIT_V(8); PG8_WAIT_L(0); PG8_BAR; PG8_MMA(1, 0, At, B0); PG8_MMA(1, 1, At, B1); PG8_BAR; PG8_SCHED;
            PG8_LDB(B0, 1, 0); PG8_LDB(B1, 1, 1); PG8_SCHED; PG8_LDA(At, 1, 0); PG8_STAGE(PG8_SA(0, 1), a2 + hstepA, voffA);
            PG8_WAIT_V(8); PG8_WAIT_L(0); PG8_BAR; PG8_MMA(0, 0, At, B0); PG8_MMA(0, 1, At, B1); PG8_BAR; PG8_SCHED;
            PG8_LDA(At, 1, 1); PG8_STAGE(PG8_SB(1, 0), b3, voffB); PG8_STAGE(PG8_SB(1, 1), b3 + hstepB, voffB); PG8_STAGE(PG8_SA(1, 0), a3, voffA);
            PG8_WAIT_V(8); PG8_WAIT_L(0); PG8_BAR; PG8_MMA(1, 0, At, B0); PG8_MMA(1, 1, At, B1); PG8_BAR; PG8_SCHED;
        }
        if (wr == 0) PG8_BAR;
        E(acc, cur, wr, wc, fr, fq);
        if (!has_next) break;
#pragma unroll
        for (int a = 0; a < 2; ++a)
#pragma unroll
            for (int b = 0; b < 2; ++b)
#pragma unroll
                for (int m = 0; m < 4; ++m)
#pragma unroll
                    for (int n = 0; n < 2; ++n) acc[a][b][m][n] = (f32x4){0.f, 0.f, 0.f, 0.f};
        cur = nxt; cA = nA; cB = nB; ++ui;
        if (wr == 1) PG8_BAR;
    }
    PG8_WAIT_V(0);
    PG8_BAR;
#undef PG8_SA
#undef PG8_SB
#undef PG8_STAGE
#undef PG8_LDA
#undef PG8_LDB
#undef PG8_MMA
#undef PG8_WAIT_V
#undef PG8_WAIT_L
#undef PG8_BAR
#undef PG8_SCHED
}
}

template <int EPI>
DI void gemm_phase(const bf16_t* A, int lda, const bf16_t* Bt, int K, int N, bf16_t* O, int ldo, char* smem, const int wid, float* knp = nullptr) {
    pg8::Gemm g; g.A = A; g.Bt = Bt; g.lda = lda; g.N = N; g.K = K;
    pg8::StaticOrder S; S.init(NTOK, N, gridDim.x, blockIdx.x);
    pg8::Epi<EPI> E; E.O = O; E.ldo = ldo; E.kn = knp; E.xch = (float*)(smem + 131072);
    pg8::gemm_phase(( LDS3 unsigned char*)smem, g, S, E, wid);
    __syncthreads();
}

DI void corr_phase(const Params& p, char* smem, const int wid) {
    pg8::Gemm g; g.A = p.P; g.Bt = RET_ST(p); g.lda = LD1; g.N = 512; g.K = 256;
    pg8::CorrOrder S; S.G = gridDim.x; S.c = blockIdx.x;
    pg8::CorrEpi E; E.C01 = RET_C01(p); E.C23 = RET_C23(p);
    pg8::gemm_phase((LDS3 unsigned char*)smem, g, S, E, wid);
    __syncthreads();
}

constexpr int KST = 272, VST = 320;
DI void attn_phase(const Params& p, char* smem, bf16_t* ybase, int ldy, const int wid) {
    const int tid = TIDX, w = wid, lane = tid & 63, l31 = lane & 31, hh = lane >> 5;
    const int rg = w >> 1, c = w & 1;
    const int pi = (l31 & 0x13) | ((l31 & 4) << 1) | ((l31 & 8) >> 1);
    const int q4 = (lane & 15) >> 2, p2 = lane & 3, blk = (lane >> 4) & 1;
    char* Kb = smem;
    char* Vb = smem + 3 * 64 * KST;
    float* X = (float*)smem + rg * (128 * 32);
    float* KM = (float*)(smem + 3 * 64 * KST + 3 * 64 * VST);
    float d1 = 0.f, d2 = 0.f;
    for (int i = 0; i < 64; ++i) { d1 += p.lq1[i] * p.lk1[i]; d2 += p.lq2[i] * p.lk2[i]; }
    const float lam_init = 0.2f;
    const float lam = __expf(d1) - __expf(d2) + lam_init;
    unsigned* ctr = (unsigned*)(p.mod + 24576 + 8192);
    int* sitem = (int*)(smem + 3 * 64 * KST + 3 * 64 * VST + 1024);
    unsigned* vflag = (unsigned*)(smem + 3 * 64 * KST + 3 * 64 * VST + 1024 + 64);
    for (;;) {
        if (tid == 0) *sitem = (int)atomicAdd(&ctr[0], 1u);
        __syncthreads();
        const int idx = __builtin_amdgcn_readfirstlane(*sitem);
        if (idx >= 2048) break;
        const int qb = 63 - (idx >> 5), bh = idx & 31, b = bh >> 3, h = bh & 7;
        const float slope2 = exp2f(-(float)(h + 1)) * LOG2E;
        bf16x8 qbias;
        {
            const float shi = bflo(pk2(slope2, 0.f));
            u32x4 qb = {0u, 0u, 0u, 0u};
            qb.x = hh == 0 ? pk2(shi, slope2 - shi) : 0u;
            qbias = __builtin_bit_cast(bf16x8, qb);
        }
        const int qpos = qb * 128 + rg * 32 + l31;
        const size_t tq = (size_t)b * SEQ + qpos;
        bf16x8 qf[4];
        {
            const bf16_t* qp = p.P + tq * LD0 + h * 128 + c * 64 + 8 * hh;
#pragma unroll
            for (int s = 0; s < 4; ++s) qf[s] = *(const bf16x8*)(qp + 16 * s);
        }
        const int mytile = 2 * qb + (rg >> 1);
        const int jmax = 2 * qb + 1;
        const int lrow = tid >> 4, lch = tid & 15;
        const bf16_t* kg = p.P + (size_t)NTOK * LD0 + (((size_t)b * 8 + h) * SEQ + lrow) * 256 + lch * 8;
        u32x4 rkA[2], rvA[2], t0k[2], t0v[2], t1k[2], t1v[2];
        {
            const int j2 = jmax >= 2 ? jmax - 2 : 0;
#pragma unroll
            for (int i = 0; i < 2; ++i) {
                const bf16_t* s0 = kg + (size_t)(jmax * 64 + 32 * i) * 256;
                const bf16_t* s1 = kg + (size_t)((jmax - 1) * 64 + 32 * i) * 256;
                const bf16_t* s2 = kg + (size_t)(j2 * 64 + 32 * i) * 256;
                t0k[i] = *(const u32x4*)s0; t0v[i] = *(const u32x4*)(s0 + 128);
                t1k[i] = *(const u32x4*)s1; t1v[i] = *(const u32x4*)(s1 + 128);
                rkA[i] = *(const u32x4*)s2; rvA[i] = *(const u32x4*)(s2 + 128);
            }
        }
        float kv0 = 0.f, kv1 = 0.f;
        if (w < 2) { const float* knp = p.mod + 24576 + ((b * 8 + h) * 2 + w) * 128; kv0 = knp[2 * lane]; kv1 = knp[2 * lane + 1]; }
        float qn;
        {
            float sq = 0.f;
#pragma unroll
            for (int s4 = 0; s4 < 4; ++s4) {
                const u32x4 u = __builtin_bit_cast(u32x4, qf[s4]);
#pragma unroll
                for (int j = 0; j < 4; ++j) sq += bflo(u[j]) * bflo(u[j]) + bfhi(u[j]) * bfhi(u[j]);
            }
            sq += __shfl_xor(sq, 32);
            qn = sqrtf(sq) * 1.001f;
        }
        if (w < 2) {
            const float v0 = kv0, v1 = kv1;
            float incl = fmaxf(v0, v1);
#pragma unroll
            for (int o = 1; o < 64; o <<= 1) { const float t = __shfl_up(incl, o); if (lane >= o) incl = fmaxf(incl, t); }
            float excl = __shfl_up(incl, 1); if (lane == 0) excl = 0.f;
            KM[w * 128 + 2 * lane] = sqrtf(fmaxf(excl, v0)) * 1.001f;
            KM[w * 128 + 2 * lane + 1] = sqrtf(incl) * 1.001f;
        }
        int wdone = 0;
        f32x16 O[4];
#pragma unroll
        for (int et = 0; et < 4; ++et)
#pragma unroll
            for (int r = 0; r < 16; ++r) O[et][r] = 0.f;
        float m = -1e30f, l = 0.f;
#pragma unroll
        for (int i = 0; i < 2; ++i) {
            *(u32x4*)(Kb + (lrow + 32 * i) * KST + lch * 16) = t0k[i];
            *(u32x4*)(Vb + (lrow + 32 * i) * VST + lch * 16) = t0v[i];
            *(u32x4*)(Kb + 64 * KST + (lrow + 32 * i) * KST + lch * 16) = t1k[i];
            *(u32x4*)(Vb + 64 * VST + (lrow + 32 * i) * VST + lch * 16) = t1v[i];
        }
        if (tid < 4) vflag[8 + 4 + tid] = 0u;
        __syncthreads();
        bf16x8 pf[2][2];
        bool havep = false;
        const bool grpA = w < 4;
        auto QS = [&](const int jt, const int buf) __attribute__((always_inline)) {
            if (jt <= mytile && !wdone) {
                const char* kb = Kb + buf * 64 * KST;
                f32x16 S[2];
#pragma unroll
                for (int kt = 0; kt < 2; ++kt) {
#pragma unroll
                    for (int r = 0; r < 16; ++r) S[kt][r] = 0.f;
                    {
                        u32x4 kbu = {0u, 0u, 0u, 0u};
                        const float kl = (float)(32 * kt + pi);
                        kbu.x = hh == 0 ? pk2(kl, kl) : 0u;
                        S[kt] = __builtin_amdgcn_mfma_f32_32x32x16_bf16(__builtin_bit_cast(bf16x8, kbu), qbias, S[kt], 0, 0, 0);
                    }
#pragma unroll
                    for (int s4 = 0; s4 < 4; ++s4) {
                        const bf16x8 kf = *(const bf16x8*)(kb + (32 * kt + pi) * KST + (c * 64 + 16 * s4 + 8 * hh) * 2);
                        S[kt] = __builtin_amdgcn_mfma_f32_32x32x16_bf16(kf, qf[s4], S[kt], 0, 0, 0);
                    }
                }
                const int dqi = qpos - jt * 64;
                if (jt == mytile) {
#pragma unroll
                    for (int kt = 0; kt < 2; ++kt)
#pragma unroll
                        for (int r = 0; r < 16; ++r) {
                            const int kloc = 32 * kt + (r & 3) + 4 * ((r >> 2) & 1) + 16 * (r >> 3) + 8 * hh;
                            S[kt][r] -= 2.f * slope2 * fmaxf((float)(kloc - dqi), 0.f);
                        }
                }
                const float u = slope2 * (float)dqi;
                float mt = -1e30f;
#pragma unroll
                for (int kt = 0; kt < 2; ++kt)
#pragma unroll
                    for (int r = 0; r < 16; ++r) mt = fmaxf(mt, S[kt][r]);
                mt -= u;
                mt = fmaxf(mt, __shfl_xor(mt, 32));
                const float mnew = fmaxf(m, mt);
                if (__any(mnew > m)) {
                    const float alpha = __builtin_amdgcn_exp2f(m - mnew);
                    l *= alpha;
#pragma unroll
                    for (int et = 0; et < 4; ++et)
#pragma unroll
                        for (int r = 0; r < 16; ++r) O[et][r] *= alpha;
                }
                m = mnew;
                const float Mt = m + u;
                const f32x2 Mt2 = {Mt, Mt};
                f32x2 l2 = {0.f, 0.f};
#pragma unroll
                for (int kt = 0; kt < 2; ++kt)
#pragma unroll
                    for (int s2 = 0; s2 < 2; ++s2) {
                        u32x4 uu;
#pragma unroll
                        for (int j = 0; j < 8; j += 2) {
                            const f32x2 x = (f32x2){S[kt][8 * s2 + j], S[kt][8 * s2 + j + 1]} - Mt2;
                            f32x2 e2; e2.x = __builtin_amdgcn_exp2f(x.x); e2.y = __builtin_amdgcn_exp2f(x.y);
                            l2 = l2 + e2;
                            uu[j >> 1] = pk2(e2.x, e2.y);
                        }
                        pf[kt][s2] = __builtin_bit_cast(bf16x8, uu);
                    }
                l += l2.x + l2.y;
                if (jt > 0) {
                    const float bound = qn * KM[c * 128 + jt - 1] + 1.0f - slope2 * (float)(qpos - (64 * (jt - 1) + 63));
                    wdone = __all(bound < m - 160.f);
                }
                havep = true;
            }
        };
        auto PV = [&](const int buf) __attribute__((always_inline)) {
            if (havep) {
                const char* vb = Vb + buf * 64 * VST;
#pragma unroll
                for (int kt = 0; kt < 2; ++kt)
#pragma unroll
                    for (int s2 = 0; s2 < 2; ++s2)
#pragma unroll
                        for (int et = 0; et < 4; ++et) {
                            const char* va = vb + (32 * kt + 16 * s2 + 8 * hh + q4) * VST + (32 * et + 16 * blk + 4 * p2) * 2;
                            const bf16x8 vf = cat4(tr_read(va), tr_read(va + 4 * VST));
                            O[et] = __builtin_amdgcn_mfma_f32_32x32x16_bf16(vf, pf[kt][s2], O[et], 0, 0, 0);
                        }
                havep = false;
            }
        };
        auto STAGE = [&](const int jt, const int dst, u32x4 (&rk)[2], u32x4 (&rv)[2]) __attribute__((always_inline)) {
            char* kd = Kb + dst * 64 * KST;
            char* vd = Vb + dst * 64 * VST;
#pragma unroll
            for (int i = 0; i < 2; ++i) {
                *(u32x4*)(kd + (lrow + 32 * i) * KST + lch * 16) = rk[i];
                *(u32x4*)(vd + (lrow + 32 * i) * VST + lch * 16) = rv[i];
            }
            const int j3 = jt >= 3 ? jt - 3 : 0;
#pragma unroll
            for (int i = 0; i < 2; ++i) {
                const bf16_t* src = kg + (size_t)(j3 * 64 + 32 * i) * 256;
                rk[i] = *(const u32x4*)src; rv[i] = *(const u32x4*)(src + 128);
            }
        };
        auto VOTE = [&](const int ps) __attribute__((always_inline)) -> bool {
            if (lane == 0) vflag[(grpA ? 0 : 8) + ps * 4 + (w & 3)] = wdone;
            __syncthreads();
            const u32x4 fa = *(const u32x4*)(vflag + ps * 4), fb = *(const u32x4*)(vflag + 8 + (ps ^ 1) * 4);
            return (fa.x & fa.y & fa.z & fa.w & fb.x & fb.y & fb.z & fb.w) != 0u;
        };
        if (!grpA) __syncthreads();
        {
            int buf = 0, dst = 2;
            for (int jt = jmax; jt >= 0; --jt) {
                QS(jt, buf);
                __syncthreads();
                PV(buf);
                STAGE(jt, dst, rkA, rvA);
                const bool alldone = VOTE((jmax - jt) & 1);
                buf = buf == 2 ? 0 : buf + 1; dst = dst == 2 ? 0 : dst + 1;
                if (alldone) break;
            }
        }
        if (grpA) __syncthreads();
        __syncthreads();
        const float lt = l + __shfl_xor(l, 32);
        const float inv = 1.f / lt;
        if (c == 1) {
            const float f = lam * inv;
#pragma unroll
            for (int et = 0; et < 4; ++et)
#pragma unroll
                for (int r = 0; r < 16; ++r) {
                    const int e = 32 * et + (r & 3) + 8 * (r >> 2) + 4 * hh;
                    X[e * 32 + l31] = O[et][r] * f;
                }
        }
        __syncthreads();
        if (c == 0) {
            float ss = 0.f;
#pragma unroll
            for (int et = 0; et < 4; ++et)
#pragma unroll
                for (int r = 0; r < 16; ++r) {
                    const int e = 32 * et + (r & 3) + 8 * (r >> 2) + 4 * hh;
                    const float o = O[et][r] * inv - X[e * 32 + l31];
                    O[et][r] = o; ss += o * o;
                }
            ss += __shfl_xor(ss, 32);
            const float rstd = rsqrtf(ss * (1.f / 128.f) + 1e-5f) * (1.f - lam_init);
            bf16_t* gp = p.P + tq * LD0 + 3072 + h * 128;
#pragma unroll
            for (int et = 0; et < 4; ++et)
#pragma unroll
                for (int g4 = 0; g4 < 4; ++g4) {
                    const int e0 = 32 * et + 8 * g4 + 4 * hh;
                    const u32x2 gv = *(const u32x2*)(gp + e0);
                    const f32x4 sg = *(const f32x4*)(p.subln + e0);
                    u32x2 y;
                    y.x = pk2(O[et][4 * g4 + 0] * rstd * sg[0] * silu_f(bflo(gv.x)), O[et][4 * g4 + 1] * rstd * sg[1] * silu_f(bfhi(gv.x)));
                    y.y = pk2(O[et][4 * g4 + 2] * rstd * sg[2] * silu_f(bflo(gv.y)), O[et][4 * g4 + 3] * rstd * sg[3] * silu_f(bfhi(gv.y)));
                    *(u32x2*)(ybase + tq * ldy + h * 128 + e0) = y;
                }
        }
        __syncthreads();
    }
}

constexpr int QST = 528;
DI void retA_phase(const Params& p, char* smem, const int wid) {
    const int tid = TIDX, w = wid, lane = tid & 63, l15 = lane & 15, quad = lane >> 4;
    char* Qs = smem;
    char* Ks = smem + 64 * QST;
    const int qrow = tid >> 5, qch = tid & 31;
    u32x4 rq[4], rk[4];
    if (blockIdx.x < 2048) {
        const int item = blockIdx.x, bh = item >> 7, n = item & 127, b = bh >> 2, h = bh & 3;
        const bf16_t* qg = p.P + ((size_t)b * SEQ + n * 64 + qrow) * LD1 + h * 256 + qch * 8;
#pragma unroll
        for (int i = 0; i < 4; ++i) { rq[i] = *(const u32x4*)(qg + (size_t)(16 * i) * LD1); rk[i] = *(const u32x4*)(qg + (size_t)(16 * i) * LD1 + 1024); }
    }
    for (int item = blockIdx.x; item < 2048; item += gridDim.x) {
        const int bh = item >> 7, h = bh & 3;
        const float lg = __log2f(1.f - exp2f(-5.f - (float)h));
#pragma unroll
        for (int i = 0; i < 4; ++i) { *(u32x4*)(Qs + (qrow + 16 * i) * QST + qch * 16) = rq[i]; *(u32x4*)(Ks + (qrow + 16 * i) * QST + qch * 16) = rk[i]; }
        __syncthreads();
        {
            const int nx = item + (int)gridDim.x < 2048 ? item + (int)gridDim.x : item;
            const int bh2 = nx >> 7, n2 = nx & 127, b2 = bh2 >> 2, h2 = bh2 & 3;
            const bf16_t* qg = p.P + ((size_t)b2 * SEQ + n2 * 64 + qrow) * LD1 + h2 * 256 + qch * 8;
#pragma unroll
            for (int i = 0; i < 4; ++i) { rq[i] = *(const u32x4*)(qg + (size_t)(16 * i) * LD1); rk[i] = *(const u32x4*)(qg + (size_t)(16 * i) * LD1 + 1024); }
        }
        const int ti = w >> 1, tj0 = 2 * (w & 1);
        f32x4 a2[2] = {(f32x4){0.f, 0.f, 0.f, 0.f}, (f32x4){0.f, 0.f, 0.f, 0.f}};
#pragma unroll
        for (int ks = 0; ks < 8; ++ks) {
            const bf16x8 qf = *(const bf16x8*)(Qs + (16 * ti + l15) * QST + (32 * ks + 8 * quad) * 2);
#pragma unroll
            for (int jj = 0; jj < 2; ++jj) {
                const bf16x8 kf = *(const bf16x8*)(Ks + (16 * (tj0 + jj) + l15) * QST + (32 * ks + 8 * quad) * 2);
                a2[jj] = __builtin_amdgcn_mfma_f32_16x16x32_bf16(kf, qf, a2[jj], 0, 0, 0);
            }
        }
        const int i = 16 * ti + l15;
        bf16_t* ag = p.H + (size_t)item * 4096 + i * 64;
#pragma unroll
        for (int jj = 0; jj < 2; ++jj) {
            float v[4];
#pragma unroll
            for (int r = 0; r < 4; ++r) {
                const int j = 16 * (tj0 + jj) + 4 * quad + r;
                const int ad = i > j ? i - j : j - i;
                v[r] = a2[jj][r] * exp2f(lg * (float)(ad + j - 64));
            }
            u32x2 o; o.x = pk2(v[0], v[1]); o.y = pk2(v[2], v[3]);
            *(u32x2*)(ag + 16 * (tj0 + jj) + 4 * quad) = o;
        }
        __syncthreads();
    }
}

constexpr int SQST = 520, SKST = 576, SVST = 192, RST = 65;
DI void scan_phase(const Params& p, char* smem, bf16_t* obase, int ldob, const int wid) {
    const int tid = TIDX, w = wid, lane = tid & 63, l31 = lane & 31, hh = lane >> 5;
    const int q4 = (lane & 15) >> 2, p2 = lane & 3, blk = (lane >> 4) & 1;
    const int dq = w >> 1, eh = w & 1;
    char* Qs = smem;
    char* Ks = smem + 64 * SQST;
    char* Vs = Ks + 64 * SKST;
    float* Red = (float*)(Vs + 64 * SVST);
    for (int item2 = blockIdx.x; item2 < 256; item2 += gridDim.x) {
        const int hf = item2 >> 7, item = item2 & 127, c0n = 64 * hf;
        const int bh = item >> 3, sl = item & 7, b = bh >> 2, h = bh & 3;
        const float lg = __log2f(1.f - exp2f(-5.f - (float)h));
        const float cd = exp2f(64.f * lg);
        const float gi0 = exp2f(lg * (float)l31), gi1 = exp2f(lg * (float)(32 + l31));
        f32x16 st[2];
#pragma unroll
        for (int dt = 0; dt < 2; ++dt)
#pragma unroll
            for (int r = 0; r < 16; ++r) st[dt][r] = 0.f;
        const bf16_t* base = p.P + ((size_t)b * SEQ + c0n * 64) * LD1;
        const int qrow = tid >> 5, qch = tid & 31, vrow = tid >> 3, vch = tid & 7;
        const bf16_t* qg = base + (size_t)qrow * LD1 + h * 256 + qch * 8;
        const bf16_t* vg = base + (size_t)vrow * LD1 + 2048 + h * 512 + sl * 64 + vch * 8;
        const bf16_t* agp = p.H + ((size_t)bh * 128 + c0n) * 4096 + l31 * 64 + 16 * dq + 8 * hh;
        u32x4 rqX[4], rkX[4], rvX, raA[2], raB[2];
#pragma unroll
        for (int i = 0; i < 4; ++i) { rqX[i] = *(const u32x4*)(qg + (size_t)(16 * i) * LD1); rkX[i] = *(const u32x4*)(qg + (size_t)(16 * i) * LD1 + 1024); }
        rvX = *(const u32x4*)vg;
#pragma unroll
        for (int i = 0; i < 4; ++i) {
            char* qd = Qs + (qrow + 16 * i) * SQST + qch * 16;
            *(u32x2*)qd = (u32x2){rqX[i].x, rqX[i].y}; *(u32x2*)(qd + 8) = (u32x2){rqX[i].z, rqX[i].w};
            *(u32x4*)(Ks + (qrow + 16 * i) * SKST + qch * 16) = rkX[i];
        }
        *(u32x4*)(Vs + vrow * SVST + vch * 16) = rvX;
        raA[0] = *(const u32x4*)agp; raA[1] = *(const u32x4*)(agp + 32 * 64);
        {
            const size_t r1 = (size_t)64 * LD1;
#pragma unroll
            for (int i = 0; i < 4; ++i) { rqX[i] = *(const u32x4*)(qg + r1 + (size_t)(16 * i) * LD1); rkX[i] = *(const u32x4*)(qg + r1 + (size_t)(16 * i) * LD1 + 1024); }
            rvX = *(const u32x4*)(vg + r1);
        }
        __syncthreads();
        auto step = [&](const int n, u32x4 (&ra)[2], u32x4 (&ran)[2], u32x4 (&rq)[4], u32x4 (&rk)[4], u32x4& rv) __attribute__((always_inline)) {
            {
                const int n1 = n + 1 < 64 ? n + 1 : 63;
                ran[0] = *(const u32x4*)(agp + (size_t)n1 * 4096); ran[1] = *(const u32x4*)(agp + (size_t)n1 * 4096 + 32 * 64);
            }
            f32x16 part[2];
#pragma unroll
            for (int it = 0; it < 2; ++it)
#pragma unroll
                for (int r = 0; r < 16; ++r) part[it][r] = 0.f;
#pragma unroll
            for (int dt = 0; dt < 2; ++dt)
#pragma unroll
                for (int s2 = 0; s2 < 2; ++s2) {
                    u32x4 su;
                    su.x = pk2(st[dt][8 * s2 + 0], st[dt][8 * s2 + 1]); su.y = pk2(st[dt][8 * s2 + 2], st[dt][8 * s2 + 3]);
                    su.z = pk2(st[dt][8 * s2 + 4], st[dt][8 * s2 + 5]); su.w = pk2(st[dt][8 * s2 + 6], st[dt][8 * s2 + 7]);
                    const bf16x8 sf = __builtin_bit_cast(bf16x8, su);
#pragma unroll
                    for (int it = 0; it < 2; ++it) {
                        const char* qa = Qs + (32 * it + l31) * SQST + (64 * dq + 32 * dt + 16 * s2 + 4 * hh) * 2;
                        const bf16x8 qf = cat4(*(const s16x4*)qa, *(const s16x4*)(qa + 16));
                        part[it] = __builtin_amdgcn_mfma_f32_32x32x16_bf16(sf, qf, part[it], 0, 0, 0);
                    }
                }
#pragma unroll
            for (int r = 0; r < 16; ++r) { part[0][r] *= gi0; part[1][r] *= gi1; }
            bf16x8 vfr[4];
            const char* vb = Vs + (8 * hh + q4) * SVST + (32 * eh + 16 * blk + 4 * p2) * 2;
#pragma unroll
            for (int ks = 0; ks < 4; ++ks) vfr[ks] = cat4(tr_read(vb + 16 * ks * SVST), tr_read(vb + (16 * ks + 4) * SVST));
            {
                const bf16x8 vsel = cat4(tr_read(vb + 16 * dq * SVST), tr_read(vb + (16 * dq + 4) * SVST));
#pragma unroll
                for (int it = 0; it < 2; ++it) part[it] = __builtin_amdgcn_mfma_f32_32x32x16_bf16(vsel, __builtin_bit_cast(bf16x8, ra[it]), part[it], 0, 0, 0);
            }
#pragma unroll
            for (int it = 0; it < 2; ++it)
#pragma unroll
                for (int r = 0; r < 16; ++r) {
                    const int e = 32 * eh + (r & 3) + 8 * (r >> 2) + 4 * hh;
                    Red[(dq * 64 + 32 * it + l31) * RST + e] = part[it][r];
                }
#pragma unroll
            for (int dt = 0; dt < 2; ++dt) {
                const char* kb = Ks + (8 * hh + q4) * SKST + (64 * dq + 32 * dt + 16 * blk + 4 * p2) * 2;
#pragma unroll
                for (int r = 0; r < 16; ++r) st[dt][r] *= cd;
#pragma unroll
                for (int ks = 0; ks < 4; ++ks) {
                    const bf16x8 kf = cat4(tr_read(kb + 16 * ks * SKST), tr_read(kb + (16 * ks + 4) * SKST));
                    st[dt] = __builtin_amdgcn_mfma_f32_32x32x16_bf16(kf, vfr[ks], st[dt], 0, 0, 0);
                }
            }
            __syncthreads();
            {
#pragma unroll
                for (int i = 0; i < 4; ++i) {
                    char* qd = Qs + (qrow + 16 * i) * SQST + qch * 16;
                    *(u32x2*)qd = (u32x2){rq[i].x, rq[i].y}; *(u32x2*)(qd + 8) = (u32x2){rq[i].z, rq[i].w};
                    *(u32x4*)(Ks + (qrow + 16 * i) * SKST + qch * 16) = rk[i];
                }
                *(u32x4*)(Vs + vrow * SVST + vch * 16) = rv;
                const int n3 = n + 2 < 64 ? n + 2 : 63;
                const size_t ro = (size_t)n3 * 64 * LD1;
#pragma unroll
                for (int i = 0; i < 4; ++i) { rq[i] = *(const u32x4*)(qg + ro + (size_t)(16 * i) * LD1); rk[i] = *(const u32x4*)(qg + ro + (size_t)(16 * i) * LD1 + 1024); }
                rv = *(const u32x4*)(vg + ro);
            }
            {
                const int i = tid >> 3, eg = tid & 7;
                float v[8];
#pragma unroll
                for (int ee = 0; ee < 8; ++ee) {
                    float sacc = 0.f;
#pragma unroll
                    for (int d4 = 0; d4 < 4; ++d4) sacc += Red[(d4 * 64 + i) * RST + 8 * eg + ee];
                    v[ee] = sacc;
                }
                u32x4 o; o.x = pk2(v[0], v[1]); o.y = pk2(v[2], v[3]); o.z = pk2(v[4], v[5]); o.w = pk2(v[6], v[7]);
                bf16_t* og = obase + ((size_t)b * SEQ + (c0n + n) * 64 + i) * ldob + h * 512 + sl * 64 + 8 * eg;
                *(u32x4*)og = o;
            }
            __syncthreads();
        };
        for (int n = 0; n < 64; n += 2) {
            step(n, raA, raB, rqX, rkX, rvX);
            step(n + 1, raB, raA, rqX, rkX, rvX);
        }
        if (hf == 0) {
            bf16_t* sg = RET_ST(p) + ((size_t)bh * 512 + sl * 64 + 32 * eh + l31) * 256 + 64 * dq + 4 * hh;
#pragma unroll
            for (int dt = 0; dt < 2; ++dt)
#pragma unroll
                for (int g4 = 0; g4 < 4; ++g4) {
                    u32x2 o; o.x = pk2(st[dt][4 * g4 + 0], st[dt][4 * g4 + 1]); o.y = pk2(st[dt][4 * g4 + 2], st[dt][4 * g4 + 3]);
                    *(u32x2*)(sg + 32 * dt + 8 * g4) = o;
                }
        }
    }
}

DI void grid_barrier(unsigned* ctr, const unsigned target, const int wid) {
    asm volatile("s_waitcnt vmcnt(0)" ::: "memory");
    __syncthreads();
    if (wid == 0 && lane_id() == 0) {
        __builtin_amdgcn_fence(__ATOMIC_RELEASE, "agent");
        asm volatile("s_waitcnt vmcnt(0)" ::: "memory");
        __hip_atomic_fetch_add(ctr, 1u, __ATOMIC_RELAXED, __HIP_MEMORY_SCOPE_AGENT);
        while (__hip_atomic_load(ctr, __ATOMIC_RELAXED, __HIP_MEMORY_SCOPE_AGENT) < target) __builtin_amdgcn_s_sleep(1);
        __builtin_amdgcn_fence(__ATOMIC_ACQUIRE, "agent");
        asm volatile("s_waitcnt vmcnt(0)" ::: "memory");
    }
    __syncthreads();
}

__global__ void __launch_bounds__(NT) mega(Params p) {
    extern __shared__ __attribute__((aligned(16))) char smem[];
    cg::grid_group grid = cg::this_grid();
    const int wid = __builtin_amdgcn_readfirstlane(threadIdx.x >> 6);
    unsigned* const gbar = (unsigned*)(p.mod + 34816);
    unsigned nbar = 0;
#define GSYNC() do { if (nbar == 0) grid.sync(); else grid_barrier(gbar, nbar * gridDim.x, wid); ++nbar; } while (0)
#define PSYNC() GSYNC()
    prep_phase(p, smem, wid);
    norm0_phase(p, wid);
    PSYNC();
    gemm_phase<0>(p.H, DM, p.Wt0in, 1024, 4096, p.P, LD0, smem, wid, p.mod + 24576);
    PSYNC();
    attn_phase(p, smem, p.P + 3072, LD0, wid);
    PSYNC();
    gemm_phase<2>(p.P + 3072, LD0, p.Wt0out, 1024, 1024, p.P, LD0, smem, wid);
    PSYNC();
    post_phase<0>(p, LD0, wid);
    PSYNC();
    gemm_phase<1>(p.H, DM, p.Wt1in, 1024, 6144, p.P, LD1, smem, wid);
    PSYNC();
    retA_phase(p, smem, wid);
    PSYNC();
    scan_phase(p, smem, p.P + 2048, LD1, wid);
    PSYNC();
    if (blockIdx.x & 1) gate1_phase(p, wid, 0);
    corr_phase(p, smem, wid);
    if (!(blockIdx.x & 1)) gate1_phase(p, wid, 0);
    PSYNC();
    gate1_phase(p, wid, 1);
    PSYNC();
    gemm_phase<2>(p.P + 4096, LD1, p.Wt1out, 2048, 1024, p.P, LD1, smem, wid);
    PSYNC();
    post_phase<1>(p, LD1, wid);
}

extern "C" void kernel_launch(void* const* d_in, const int* in_sizes, int n_in, void* d_out, int out_size, void* d_ws, size_t ws_size, hipStream_t stream) {
    static int grid_blocks = 0;
    if (!grid_blocks) {
        hipFuncSetAttribute((const void*)mega, hipFuncAttributeMaxDynamicSharedMemorySize, SMEM_BYTES);
        int dev = 0, cus = 0, per_cu = 0;
        hipGetDevice(&dev);
        hipDeviceGetAttribute(&cus, hipDeviceAttributeMultiprocessorCount, dev);
        hipOccupancyMaxActiveBlocksPerMultiprocessor(&per_cu, mega, NT, SMEM_BYTES);
        if (per_cu < 1) per_cu = 1;
        if (per_cu > 1) per_cu = 1;
        grid_blocks = cus * per_cu;
    }
    Params p{};
    p.x = (const float*)d_in[0]; p.c = (const float*)d_in[1]; p.ada_w = (const float*)d_in[2]; p.ada_b = (const float*)d_in[3];
    p.pre_gain = (const float*)d_in[4]; p.post_gain = (const float*)d_in[5]; p.da_w_in = (const float*)d_in[6]; p.da_w_out = (const float*)d_in[7];
    p.lq1 = (const float*)d_in[8]; p.lk1 = (const float*)d_in[9]; p.lq2 = (const float*)d_in[10]; p.lk2 = (const float*)d_in[11];
    p.subln = (const float*)d_in[12]; p.ret_w_in = (const float*)d_in[13]; p.ret_w_out = (const float*)d_in[14];
    p.out = (float*)d_out;
    char* ws = (char*)d_ws;
    p.Wt0in = (bf16_t*)(ws + 0);
    p.Wt0out = (bf16_t*)(ws + 8388608);
    p.Wt1in = (bf16_t*)(ws + 10485760);
    p.Wt1out = (bf16_t*)(ws + 23068672);
    p.mod = (float*)(ws + 27262976);
    p.H = (bf16_t*)(ws + 27525120);
    p.P = (bf16_t*)(ws + 94633984);
    hipMemsetAsync((char*)d_ws + 27262976 + 131072, 0, 16384, stream);
    void* args[] = {&p};
    hipError_t e = hipLaunchCooperativeKernel((void*)mega, dim3(grid_blocks), dim3(NT), args, SMEM_BYTES, stream);
    if (e != hipSuccess) fprintf(stderr, "cooperative launch failed: %s (grid %d)\n", hipGetErrorString(e), grid_blocks);
}
```

```cpp
#include <hip/hip_runtime.h>
#include <hip/hip_cooperative_groups.h>
#include <cstdio>
#include <cstdint>
namespace cg = cooperative_groups;

typedef unsigned short bf16_t;
typedef short bf16x8 __attribute__((ext_vector_type(8)));
typedef short s16x4 __attribute__((ext_vector_type(4)));
typedef float f32x4 __attribute__((ext_vector_type(4)));
typedef float f32x16 __attribute__((ext_vector_type(16)));
typedef float f32x2 __attribute__((ext_vector_type(2)));
typedef __bf16 bf16x2_t __attribute__((ext_vector_type(2)));
typedef unsigned u32x2 __attribute__((ext_vector_type(2)));
typedef unsigned u32x4 __attribute__((ext_vector_type(4)));
#define DI __device__ __forceinline__
#define LDS3 __attribute__((address_space(3)))

constexpr int DM = 1024, NB = 4, SEQ = 8192, NTOK = NB * SEQ;
constexpr int NT = 512;
constexpr int LD0 = 4096, LD1 = 6144;
constexpr float LOG2E = 1.4426950408889634f;
constexpr float QSCALE = 0.125f * LOG2E;
constexpr int SMEM_BYTES = 149504;

struct Params {
    const float *x, *c, *ada_w, *ada_b, *pre_gain, *post_gain, *da_w_in, *da_w_out, *lq1, *lk1, *lq2, *lk2, *subln, *ret_w_in, *ret_w_out;
    float* out;
    bf16_t *Wt0in, *Wt0out, *Wt1in, *Wt1out, *H, *P;
    float* mod;
};

DI unsigned pk2(float a, float b) { f32x2 v = {a, b}; bf16x2_t r = __builtin_convertvector(v, bf16x2_t); return __builtin_bit_cast(unsigned, r); }
DI float bflo(unsigned u) { return __uint_as_float(u << 16); }
DI float bfhi(unsigned u) { return __uint_as_float(u & 0xffff0000u); }
DI float4 ldnt_f4(const float* p) { const f32x4 v = __builtin_nontemporal_load((const f32x4*)p); return make_float4(v[0], v[1], v[2], v[3]); }
DI void stnt_f4(float* p, const float4 v) { const f32x4 t = {v.x, v.y, v.z, v.w}; __builtin_nontemporal_store(t, (f32x4*)p); }
DI u32x4 ldnt_u4(const void* p) { return __builtin_nontemporal_load((const u32x4*)p); }
DI u32x2 ldnt_u2(const void* p) { return __builtin_nontemporal_load((const u32x2*)p); }
DI void stnt_u4(void* p, const u32x4 v) { __builtin_nontemporal_store(v, (u32x4*)p); }
DI void stnt_u2(void* p, const u32x2 v) { __builtin_nontemporal_store(v, (u32x2*)p); }
DI float wave_sum(float v) {
#pragma unroll
    for (int o = 32; o; o >>= 1) v += __shfl_xor(v, o);
    return v;
}
DI float silu_f(float x) { return x * __builtin_amdgcn_rcpf(1.f + __builtin_amdgcn_exp2f(-x * LOG2E)); }
DI int lane_id() { int l; asm volatile("v_mbcnt_lo_u32_b32 %0, -1, 0\n\tv_mbcnt_hi_u32_b32 %0, -1, %0" : "=v"(l)); return l; }
#define TIDX (wid * 64 + lane_id())
#define RET_ST(p) ((p).P + (size_t)NTOK * LD1)
#define RET_C01(p) ((p).H)
#define RET_C23(p) ((p).P + (size_t)NTOK * LD1 + 2097152)
DI bf16x8 cat4(s16x4 a, s16x4 b) { return __builtin_shufflevector(a, b, 0, 1, 2, 3, 4, 5, 6, 7); }
DI s16x4 tr_read(const char* p) { return __builtin_amdgcn_ds_read_tr16_b64_v4i16((LDS3 s16x4*)p); }

DI void transpose_tile(const float* __restrict__ W, int K, int N, bf16_t* __restrict__ Wt, int tk, int tn, char* smem, const int wid) {
    float* s = (float*)smem;
    const int tid = TIDX;
    const int r = tid >> 4, c4 = (tid & 15) * 4;
#pragma unroll
    for (int p = 0; p < 2; ++p) {
        const int k = r + 32 * p;
        const float4 v = ldnt_f4(W + (size_t)(tk * 64 + k) * N + tn * 64 + c4);
        s[k * 65 + c4 + 0] = v.x; s[k * 65 + c4 + 1] = v.y; s[k * 65 + c4 + 2] = v.z; s[k * 65 + c4 + 3] = v.w;
    }
    __syncthreads();
    const int n = tid >> 3, kc = (tid & 7) * 8;
    u32x4 o;
    o.x = pk2(s[(kc + 0) * 65 + n], s[(kc + 1) * 65 + n]);
    o.y = pk2(s[(kc + 2) * 65 + n], s[(kc + 3) * 65 + n]);
    o.z = pk2(s[(kc + 4) * 65 + n], s[(kc + 5) * 65 + n]);
    o.w = pk2(s[(kc + 6) * 65 + n], s[(kc + 7) * 65 + n]);
    *(u32x4*)(Wt + (size_t)(tn * 64 + n) * K + tk * 64 + kc) = o;
    __syncthreads();
}

DI void mod_item(const Params& p, int item, char* smem, const int wid) {
    float* cond = (float*)smem;
    float* red = (float*)(smem + 16384);
    const int tid = TIDX, w = wid, lane = tid & 63;
    const int l = item / 48, e0 = (item % 48) * 64;
#pragma unroll
    for (int i = 0; i < 8; ++i) { const int idx = tid + 512 * i; cond[idx] = silu_f(p.c[idx]); }
    __syncthreads();
    float a0 = 0.f, a1 = 0.f, a2 = 0.f, a3 = 0.f;
    const float* wp = p.ada_w + (size_t)l * 1024 * 3072 + e0 + lane;
#pragma unroll 16
    for (int d = w * 128; d < w * 128 + 128; ++d) {
        const float wv = wp[(size_t)d * 3072];
        a0 += cond[d] * wv; a1 += cond[1024 + d] * wv; a2 += cond[2048 + d] * wv; a3 += cond[3072 + d] * wv;
    }
    red[(w * 4 + 0) * 64 + lane] = a0; red[(w * 4 + 1) * 64 + lane] = a1; red[(w * 4 + 2) * 64 + lane] = a2; red[(w * 4 + 3) * 64 + lane] = a3;
    __syncthreads();
    if (tid < 256) {
        const int b = tid >> 6, e = tid & 63;
        float s = p.ada_b[l * 3072 + e0 + e];
#pragma unroll
        for (int ww = 0; ww < 8; ++ww) s += red[(ww * 4 + b) * 64 + e];
        p.mod[(l * 4 + b) * 3072 + e0 + e] = s;
    }
    asm volatile("s_waitcnt vmcnt(0)" ::: "memory");
    __syncthreads();
    if (tid == 0) {
        __builtin_amdgcn_fence(__ATOMIC_RELEASE, "agent");
        asm volatile("s_waitcnt vmcnt(0)" ::: "memory");
        __hip_atomic_fetch_add((unsigned*)(p.mod + 34880), 1u, __ATOMIC_RELAXED, __HIP_MEMORY_SCOPE_AGENT);
    }
}

DI void prep_phase(const Params& p, char* smem, const int wid) {
    const int G = gridDim.x;
    { const int t0 = TIDX; if (blockIdx.x == 0 && t0 < 8) ((unsigned*)(p.mod + 24576 + 8192))[t0 * 16] = 0u; if (blockIdx.x == 0 && t0 == 8) *(unsigned*)(p.mod + 34816) = 0u; }
    for (int it = blockIdx.x; it < 96 + 3328; it += G) {
        if (it < 96) { mod_item(p, it, smem, wid); continue; }
        int t = it - 96;
        if (t < 1024) { transpose_tile(p.da_w_in, 1024, 4096, p.Wt0in, t & 15, t >> 4, smem, wid); continue; }
        t -= 1024;
        if (t < 256) { transpose_tile(p.da_w_out, 1024, 1024, p.Wt0out, t & 15, t >> 4, smem, wid); continue; }
        t -= 256;
        if (t < 1536) { transpose_tile(p.ret_w_in, 1024, 6144, p.Wt1in, t & 15, t >> 4, smem, wid); continue; }
        t -= 1536;
        transpose_tile(p.ret_w_out, 2048, 1024, p.Wt1out, t & 31, t >> 5, smem, wid);
    }
    if (wid == 0 && lane_id() == 0) {
        unsigned* mf = (unsigned*)(p.mod + 34880);
        while (__hip_atomic_load(mf, __ATOMIC_RELAXED, __HIP_MEMORY_SCOPE_AGENT) < 96u) __builtin_amdgcn_s_sleep(2);
        __builtin_amdgcn_fence(__ATOMIC_ACQUIRE, "agent");
        asm volatile("s_waitcnt vmcnt(0)" ::: "memory");
    }
    __syncthreads();
}

DI void norm0_phase(const Params& p, const int wid) {
    const int w = wid, lane = lane_id();
    const int stride = gridDim.x * 8;
    for (int row0 = blockIdx.x * 8 + w; row0 < NTOK; row0 += 2 * stride) {
        float4 v[2][4];
        float ss[2] = {0.f, 0.f};
#pragma unroll
        for (int r = 0; r < 2; ++r) {
            const int row = row0 + r * stride < NTOK ? row0 + r * stride : row0;
            const float* xr = p.x + (size_t)row * DM;
#pragma unroll
            for (int i = 0; i < 4; ++i) v[r][i] = ldnt_f4(xr + i * 256 + lane * 4);
        }
#pragma unroll
        for (int r = 0; r < 2; ++r) {
#pragma unroll
            for (int i = 0; i < 4; ++i) ss[r] += v[r][i].x * v[r][i].x + v[r][i].y * v[r][i].y + v[r][i].z * v[r][i].z + v[r][i].w * v[r][i].w;
            ss[r] = wave_sum(ss[r]);
        }
#pragma unroll
        for (int r = 0; r < 2; ++r) {
            const int row = row0 + r * stride;
            if (row >= NTOK) break;
            const float rstd = rsqrtf(ss[r] * (1.f / DM) + 1e-6f);
            const float* md = p.mod + (size_t)(row / SEQ) * 3072;
#pragma unroll
            for (int i = 0; i < 4; ++i) {
                const int d = i * 256 + lane * 4;
                const float4 g = *(const float4*)(p.pre_gain + d), sh = *(const float4*)(md + d), sc = *(const float4*)(md + 1024 + d);
                u32x2 o;
                o.x = pk2(v[r][i].x * rstd * g.x * (1.f + sc.x) + sh.x, v[r][i].y * rstd * g.y * (1.f + sc.y) + sh.y);
                o.y = pk2(v[r][i].z * rstd * g.z * (1.f + sc.z) + sh.z, v[r][i].w * rstd * g.w * (1.f + sc.w) + sh.w);
                stnt_u2(p.H + (size_t)row * DM + d, o);
            }
        }
    }
}

template <int LAYER>
DI void post_phase(const Params& p, int ldp, const int wid) {
    const int w = wid, lane = lane_id();
    const int stride = gridDim.x * 8;
    for (int row0 = blockIdx.x * 8 + w; row0 < NTOK; row0 += 2 * stride) {
        float4 y[2][4], xv[2][4];
        float ss[2] = {0.f, 0.f};
#pragma unroll
        for (int r = 0; r < 2; ++r) {
            const int row = row0 + r * stride < NTOK ? row0 + r * stride : row0;
            const bf16_t* yr = p.P + (size_t)row * ldp;
            const float* xr = (LAYER == 0 ? p.x : p.out) + (size_t)row * DM;
#pragma unroll
            for (int i = 0; i < 4; ++i) {
                const u32x2 yb = ldnt_u2(yr + i * 256 + lane * 4);
                y[r][i].x = bflo(yb.x); y[r][i].y = bfhi(yb.x); y[r][i].z = bflo(yb.y); y[r][i].w = bfhi(yb.y);
                xv[r][i] = ldnt_f4(xr + i * 256 + lane * 4);
            }
        }
#pragma unroll
        for (int r = 0; r < 2; ++r) {
#pragma unroll
            for (int i = 0; i < 4; ++i) ss[r] += y[r][i].x * y[r][i].x + y[r][i].y * y[r][i].y + y[r][i].z * y[r][i].z + y[r][i].w * y[r][i].w;
            ss[r] = wave_sum(ss[r]);
        }
#pragma unroll
        for (int r = 0; r < 2; ++r) {
            const int row = row0 + r * stride;
            if (row >= NTOK) break;
            const float rstd = rsqrtf(ss[r] * (1.f / DM) + 1e-6f);
            const int b = row / SEQ;
            const float* md = p.mod + (size_t)(LAYER * 4 + b) * 3072;
            float ss1 = 0.f;
#pragma unroll
            for (int i = 0; i < 4; ++i) {
                const int d = i * 256 + lane * 4;
                const float4 g = *(const float4*)(p.post_gain + LAYER * DM + d), gt = *(const float4*)(md + 2048 + d);
                float4& x = xv[r][i]; const float4 yy = y[r][i];
                x.x += gt.x * yy.x * rstd * g.x; x.y += gt.y * yy.y * rstd * g.y; x.z += gt.z * yy.z * rstd * g.z; x.w += gt.w * yy.w * rstd * g.w;
                stnt_f4(p.out + (size_t)row * DM + d, x);
                ss1 += x.x * x.x + x.y * x.y + x.z * x.z + x.w * x.w;
            }
            if (LAYER == 0) {
                ss1 = wave_sum(ss1);
                const float r1 = rsqrtf(ss1 * (1.f / DM) + 1e-6f);
                const float* m1 = p.mod + (size_t)(4 + b) * 3072;
#pragma unroll
                for (int i = 0; i < 4; ++i) {
                    const int d = i * 256 + lane * 4;
                    const float4 g = *(const float4*)(p.pre_gain + DM + d), sh = *(const float4*)(m1 + d), sc = *(const float4*)(m1 + 1024 + d);
                    const float4 x = xv[r][i];
                    u32x2 o;
                    o.x = pk2(x.x * r1 * g.x * (1.f + sc.x) + sh.x, x.y * r1 * g.y * (1.f + sc.y) + sh.y);
                    o.y = pk2(x.z * r1 * g.z * (1.f + sc.z) + sh.z, x.w * r1 * g.w * (1.f + sc.w) + sh.w);
                    stnt_u2(p.H + (size_t)row * DM + d, o);
                }
            }
        }
    }
}

DI void gate1_phase(const Params& p, const int wid, const int half) {
    const int w = wid, lane = lane_id();
    for (int rr = blockIdx.x * 8 + w; rr < NTOK / 2; rr += gridDim.x * 8) {
        const int row = (rr >> 12) * SEQ + half * 4096 + (rr & 4095);
        bf16_t* pr = p.P + (size_t)row * LD1;
        const int spos = row & (SEQ - 1), bb = row >> 13;
        const bf16_t* cr = (bb < 2 ? RET_C01(p) : RET_C23(p)) + ((size_t)(bb & 1) * 4096 + (spos - 4096)) * 2048;
        u32x4 o[4], g[4];
        float rstd[4];
#pragma unroll
        for (int i = 0; i < 4; ++i) {
            o[i] = ldnt_u4(pr + 2048 + i * 512 + lane * 8);
            g[i] = ldnt_u4(pr + 4096 + i * 512 + lane * 8);
            if (spos >= 4096) {
                const u32x4 cv = ldnt_u4(cr + i * 512 + lane * 8);
#pragma unroll
                for (int j = 0; j < 4; ++j) o[i][j] = pk2(bflo(o[i][j]) + bflo(cv[j]), bfhi(o[i][j]) + bfhi(cv[j]));
            }
            float ss = 0.f;
#pragma unroll
            for (int j = 0; j < 4; ++j) { const float a = bflo(o[i][j]), b2 = bfhi(o[i][j]); ss += a * a + b2 * b2; }
            ss = wave_sum(ss);
            rstd[i] = rsqrtf(ss * (1.f / 512.f) + 1e-5f);
        }
#pragma unroll
        for (int i = 0; i < 4; ++i) {
            u32x4 y;
#pragma unroll
            for (int j = 0; j < 4; ++j)
                y[j] = pk2(silu_f(bflo(g[i][j])) * bflo(o[i][j]) * rstd[i], silu_f(bfhi(g[i][j])) * bfhi(o[i][j]) * rstd[i]);
            stnt_u4(pr + 4096 + i * 512 + lane * 8, y);
        }
    }
}

namespace pg8 {
constexpr int BM = 256, BK = 64, HALF = 128, HTB = HALF * BK * 2, NXCD = 8, WGM = 8;
DI int lds_byte(int r, int c) { const int st = (r >> 4) * 2 + (c >> 5), rr = r & 15, cc = c & 31, ob = rr * 64 + cc * 2; return st * 1024 + (ob ^ (((ob >> 9) & 1) << 5)); }
DI void stage_rc(int b, int& R, int& C) { const int st = b / 1024, sb = b % 1024, swz = sb ^ (((sb >> 9) & 1) << 5); R = (st >> 1) * 16 + swz / 64; C = (st & 1) * 32 + (swz % 64) / 2; }
DI int perm32(int rho) { const int n = rho >> 4, i = rho & 15; return 8 * (i >> 2) + 4 * n + (i & 3); }
struct Unit { int pm, pn; };
struct Gemm { const bf16_t* A; const bf16_t* Bt; int lda, N, K; };
struct StaticOrder {
    int nM, nN, nwg, G, c;
    DI void init(int M, int N, int G_, int c_) { nM = M / BM; nN = N / BM; nwg = nM * nN; G = G_; c = c_; }
    DI bool next(int i, Unit& u) const {
        const long L = (long)i * G + c; if (L >= nwg) return false;
        int wgid = (int)L; { const int q = nwg / NXCD, r = nwg % NXCD, xcd = wgid % NXCD, off = wgid / NXCD; wgid = (xcd < r ? xcd * (q + 1) : r * (q + 1) + (xcd - r) * q) + off; }
        const int nig = WGM * nN, gid = wgid / nig, fm = gid * WGM, gsz = (nM - fm) < WGM ? (nM - fm) : WGM;
        u.pm = fm + ((wgid % nig) % gsz); u.pn = (wgid % nig) / gsz; return true;
    }
    DI size_t a_off(const Unit& u, const Gemm& g) const { return (size_t)u.pm * (size_t)(2 * HALF) * g.lda * 2; }
    DI size_t b_off(const Unit& u, const Gemm& g) const { return (size_t)u.pn * (size_t)(2 * HALF) * g.K * 2; }
};
struct CorrOrder {
    int G, c;
    DI bool next(int i, Unit& u) const { const int idx = i * G + c; if (idx >= 512) return false; u.pm = idx >> 1; u.pn = idx & 1; return true; }
    DI size_t a_off(const Unit& u, const Gemm&) const { const int bh = u.pm >> 4, m = u.pm & 15, b = bh >> 2, h = bh & 3; return (((size_t)b * SEQ + 4096 + 256 * m) * LD1 + h * 256) * 2; }
    DI size_t b_off(const Unit& u, const Gemm&) const { const int bh = u.pm >> 4; return ((size_t)bh * 512 + 256 * u.pn) * 256 * 2; }
};
struct CorrEpi {
    bf16_t *C01, *C23;
    DI void operator()(const f32x4 (&acc)[2][2][4][2], const Unit& u, int wr, int wc, int fr, int fq) const {
        const int bh = u.pm >> 4, m = u.pm & 15, b = bh >> 2, h = bh & 3;
        const float lg = __log2f(1.f - exp2f(-5.f - (float)h));
        const size_t boff = (size_t)(b >> 1) * (size_t)(C23 - C01) + ((size_t)(b & 1) * 4096 + 256 * m) * 2048 + h * 512 + 256 * u.pn;
        bf16_t* cb = C01 + boff + (size_t)(wr * 64 + fr) * 2048 + wc * 32 + 8 * fq;
#pragma unroll
        for (int ai = 0; ai < 2; ++ai)
#pragma unroll
            for (int mm = 0; mm < 4; ++mm) {
                const int r = ai * HALF + wr * 64 + mm * 16 + fr;
                const float sc = __builtin_amdgcn_exp2f(lg * (float)(256 * m + r));
#pragma unroll
                for (int bj = 0; bj < 2; ++bj) {
                    const f32x4 v0 = acc[ai][bj][mm][0], v1 = acc[ai][bj][mm][1];
                    u32x4 wv;
                    wv.x = pk2(sc * v0[0], sc * v0[1]); wv.y = pk2(sc * v0[2], sc * v0[3]); wv.z = pk2(sc * v1[0], sc * v1[1]); wv.w = pk2(sc * v1[2], sc * v1[3]);
                    *(u32x4*)(cb + (ai * HALF + mm * 16) * 2048 + bj * HALF) = wv;
                }
                asm volatile("" ::: "memory");
            }
    }
};

template <int EPI> struct Epi {
    bf16_t* O; int ldo;
    float* kn; float* xch;
    DI void operator()(const f32x4 (&acc)[2][2][4][2], const Unit& u, int wr, int wc, int fr, int fq) const {
        const int n0 = u.pn * BM;
#pragma unroll
        for (int ai = 0; ai < 2; ++ai)
#pragma unroll
            for (int m = 0; m < 4; ++m) {
                const int tok = u.pm * BM + ai * HALF + wr * 64 + m * 16 + fr;
                float sc = 1.f;
                if (EPI == 0) { if (n0 < 1024) sc = QSCALE; }
                if (EPI == 1) {
                    if (n0 >= 1024 && n0 < 2048) {
                        const int hk = (n0 - 1024) >> 8;
                        const float lgk = __log2f(1.f - exp2f(-5.f - (float)hk));
                        sc = 0.0625f * exp2f(lgk * (float)(64 - (tok & 63)));
                    }
                }
#pragma unroll
                for (int bj = 0; bj < 2; ++bj) {
                    const int c0 = n0 + bj * HALF + wc * 32 + 8 * fq;
                    const f32x4 v0 = acc[ai][bj][m][0], v1 = acc[ai][bj][m][1];
                    {
                        u32x4 wv; wv.x = pk2(v0[0] * sc, v0[1] * sc); wv.y = pk2(v0[2] * sc, v0[3] * sc); wv.z = pk2(v1[0] * sc, v1[1] * sc); wv.w = pk2(v1[2] * sc, v1[3] * sc);
                        if (EPI == 0 && n0 >= 1024 && n0 < 2048) {
                            float sq = 0.f;
#pragma unroll
                            for (int j = 0; j < 4; ++j) { const float a = bflo(wv[j]), c2 = bfhi(wv[j]); sq += a * a + c2 * c2; }
                            sq += __shfl_xor(sq, 16); sq += __shfl_xor(sq, 32);
                            if (fq == 0) xch[(((wr * 4 + wc) * 2 + ai) * 4 + m) * 32 + fr * 2 + bj] = sq;
                        }
                        if (EPI == 0 && n0 >= 1024 && n0 < 3072) {
                            const int cc = c0 - 1024, r = cc >> 10, hd = (cc >> 7) & 7, wi = cc & 127;
                            bf16_t* kv = O + (size_t)NTOK * LD0;
                            *(u32x4*)(kv + (((size_t)(tok >> 13) * 8 + hd) * SEQ + (tok & (SEQ - 1))) * 256 + r * 128 + wi) = wv;
                        } else
                        if (EPI == 1 && n0 >= 4096) stnt_u4(O + (size_t)tok * ldo + c0, wv);
                        else *(u32x4*)(O + (size_t)tok * ldo + c0) = wv;
                    }
                }
            }
        if (EPI == 0 && n0 >= 1024 && n0 < 2048) {
            __syncthreads();
            const int lane = fr + 16 * fq;
            if ((wc & 1) == 0) {
#pragma unroll
                for (int ai = 0; ai < 2; ++ai)
#pragma unroll
                    for (int bj = 0; bj < 2; ++bj) {
                        float mx = 0.f;
#pragma unroll
                        for (int m = 0; m < 4; ++m) {
                            const int o = (ai * 4 + m) * 32 + fr * 2 + bj;
                            mx = fmaxf(mx, xch[(wr * 4 + wc) * 256 + o] + xch[(wr * 4 + wc + 1) * 256 + o]);
                        }
                        mx = fmaxf(mx, __shfl_xor(mx, 1)); mx = fmaxf(mx, __shfl_xor(mx, 2)); mx = fmaxf(mx, __shfl_xor(mx, 4)); mx = fmaxf(mx, __shfl_xor(mx, 8));
                        if (lane == 0) {
                            const int tok0 = u.pm * BM + ai * HALF + wr * 64, b = tok0 >> 13, jt = (tok0 & (SEQ - 1)) >> 6;
                            const int cb = 2 * bj + (wc >> 1), h = ((n0 - 1024) >> 7) + (cb >> 1), c = cb & 1;
                            kn[((b * 8 + h) * 2 + c) * 128 + jt] = mx;
                        }
                    }
            }
            __syncthreads();
        }
    }
};

template <class EpiT, class SchedT>
DI void gemm_phase(LDS3 unsigned char* lds, const Gemm g, const SchedT& S, const EpiT& E, const int wid) {
    const int tid = TIDX, lane = tid & 63, wr = wid >> 2, wc = wid & 3, fr = lane & 15, fq = lane >> 4;
    const int K = g.K, nt = K / BK, lda = g.lda;
    unsigned voffA[2], voffB[2];
#pragma unroll
    for (int i = 0; i < 2; ++i) { int R, C; stage_rc(tid * 16 + i * 8192, R, C); const int Rb = (R & ~31) + perm32(R & 31);
        voffA[i] = (unsigned)(R * lda + C) * 2u; voffB[i] = (unsigned)(Rb * K + C) * 2u; }
    const size_t kstep = (size_t)(BK * 2);
    const size_t hstepA = (size_t)HALF * lda * 2, hstepB = (size_t)HALF * K * 2;
        const unsigned ldsw = (unsigned)wid * 1024u;
    const int aoff = lds_byte(wr * 64 + fr, fq * 8), boff = lds_byte(wc * 32 + fr, fq * 8);
#define PG8_SA(b, h) (((b) * 2 + (h)) * HTB)
#define PG8_SB(b, h) ((4 + (b) * 2 + (h)) * HTB)
#define PG8_STAGE(bufoff, gbase, voff) do { _Pragma("unroll") for (int _i = 0; _i < 2; ++_i) \
        __builtin_amdgcn_global_load_lds((const unsigned*)((const char*)(gbase) + (voff)[_i]), (LDS3 unsigned*)(lds + (bufoff) + ldsw + _i * 8192), 16, 0, 0); } while (0)
#define PG8_LDA(dst, b, h) do { _Pragma("unroll") for (int m = 0; m < 4; ++m) _Pragma("unroll") for (int k = 0; k < 2; ++k) dst[m][k] = *(const LDS3 bf16x8*)(lds + PG8_SA(b, h) + aoff + m * 2048 + k * 1024); } while (0)
#define PG8_LDB(dst, b, h) do { _Pragma("unroll") for (int n = 0; n < 2; ++n) _Pragma("unroll") for (int k = 0; k < 2; ++k) dst[n][k] = *(const LDS3 bf16x8*)(lds + PG8_SB(b, h) + boff + n * 2048 + k * 1024); } while (0)
#define PG8_MMA(ai, bj, At, Bt) do { __builtin_amdgcn_s_setprio(1); _Pragma("unroll") for (int m = 0; m < 4; ++m) _Pragma("unroll") for (int n = 0; n < 2; ++n) _Pragma("unroll") for (int k = 0; k < 2; ++k) \
        acc[ai][bj][m][n] = __builtin_amdgcn_mfma_f32_16x16x32_bf16(Bt[n][k], At[m][k], acc[ai][bj][m][n], 0, 0, 0); __builtin_amdgcn_s_setprio(0); } while (0)
#define PG8_WAIT_V(n) asm volatile("s_waitcnt vmcnt(" #n ")" ::: "memory")
#define PG8_WAIT_L(n) asm volatile("s_waitcnt lgkmcnt(" #n ")" ::: "memory")
#define PG8_BAR __builtin_amdgcn_s_barrier()
#define PG8_SCHED __builtin_amdgcn_sched_barrier(0)
    Unit cur, nxt; int ui = 0;
    if (!S.next(0, cur)) return;
    f32x4 acc[2][2][4][2];
#pragma unroll
    for (int a = 0; a < 2; ++a)
#pragma unroll
        for (int b = 0; b < 2; ++b)
#pragma unroll
            for (int m = 0; m < 4; ++m)
#pragma unroll
                for (int n = 0; n < 2; ++n) acc[a][b][m][n] = (f32x4){0.f, 0.f, 0.f, 0.f};
    bf16x8 At[4][2], B0[2][2], B1[2][2];
    const char* cA = (const char*)g.A + S.a_off(cur, g); const char* cB = (const char*)g.Bt + S.b_off(cur, g);
    PG8_STAGE(PG8_SB(0, 0), cB, voffB); PG8_STAGE(PG8_SB(0, 1), cB + hstepB, voffB); PG8_STAGE(PG8_SA(0, 0), cA, voffA); PG8_STAGE(PG8_SA(0, 1), cA + hstepA, voffA);
    if (wr == 1) PG8_BAR;
    PG8_WAIT_V(2); PG8_BAR;
    PG8_STAGE(PG8_SB(1, 0), cB + kstep, voffB); PG8_STAGE(PG8_SA(1, 0), cA + kstep, voffA); PG8_STAGE(PG8_SB(1, 1), cB + hstepB + kstep, voffB);
    PG8_WAIT_V(6); PG8_BAR;
    for (;;) {
        const bool has_next = S.next(ui + 1, nxt);
        const char* nA = has_next ? (const char*)g.A + S.a_off(nxt, g) : cA; const char* nB = has_next ? (const char*)g.Bt + S.b_off(nxt, g) : cB;
        for (int t = 0; t < nt; t += 2) {
            const bool last = (t == nt - 2);
            const char* a1 = cA + (size_t)(t + 1) * kstep;
            const char* a2 = last ? nA : cA + (size_t)(t + 2) * kstep; const char* b2 = last ? nB : cB + (size_t)(t + 2) * kstep;
            const char* a3 = a2 + kstep; const char* b3 = b2 + kstep;
            PG8_LDB(B0, 0, 0); PG8_LDB(B1, 0, 1); PG8_SCHED; PG8_LDA(At, 0, 0); PG8_STAGE(PG8_SA(1, 1), a1 + hstepA, voffA);
            PG8_WAIT_V(8); PG8_WAIT_L(0); PG8_BAR; PG8_MMA(0, 0, At, B0); PG8_MMA(0, 1, At, B1); PG8_BAR; PG8_SCHED;
            PG8_LDA(At, 0, 1); PG8_STAGE(PG8_SB(0, 0), b2, voffB); PG8_STAGE(PG8_SB(0, 1), b2 + hstepB, voffB); PG8_STAGE(PG8_SA(0, 0), a2, voffA);
            PG8_WAIT_V(8); PG8_WAIT_L(0); PG8_BAR; PG8_MMA(1, 0, At, B0); PG8_MMA(1, 1, At, B1); PG8_BAR; PG8_SCHED;
            PG8_LDB(B0, 1, 0); PG8_LDB(B1, 1, 1); PG8_SCHED; PG8_LDA(At, 1, 0); PG8_STAGE(PG8_SA(0, 1), a2 + hstepA, voffA);
            PG8_WAIT_V(8); PG8_WAIT_L(0); PG8_BAR; PG8_MMA(0, 0, At, B0); PG8_MMA(0, 1, At, B1); PG8_BAR; PG8_SCHED;
            PG8_LDA(At, 1, 1); PG8_STAGE(PG8_SB(1, 0), b3, voffB); PG8_STAGE(PG8_SB(1, 1), b3 + hstepB, voffB); PG8_STAGE(PG8_SA(1, 0), a3, voffA);
            PG8_WAIT_V(8); PG8_WAIT_L(0); PG8_BAR; PG8_MMA(1, 0, At, B0); PG8_MMA(1, 1, At, B1); PG8_BAR; PG8_SCHED;
        }
        if (wr == 0) PG8_BAR;
        E(acc, cur, wr, wc, fr, fq);
        if (!has_next) break;
#pragma unroll
        for (int a = 0; a < 2; ++a)
#pragma unroll
            for (int b = 0; b < 2; ++b)
#pragma unroll
                for (int m = 0; m < 4; ++m)
#pragma unroll
                    for (int n = 0; n < 2; ++n) acc[a][b][m][n] = (f32x4){0.f, 0.f, 0.f, 0.f};
        cur = nxt; cA = nA; cB = nB; ++ui;
        if (wr == 1) PG8_BAR;
    }
    PG8_WAIT_V(0);
    PG8_BAR;
#undef PG8_SA
#undef PG8_SB
#undef PG8_STAGE
#undef PG8_LDA
#undef PG8_LDB
#undef PG8_MMA
#undef PG8_WAIT_V
#undef PG8_WAIT_L
#undef PG8_BAR
#undef PG8_SCHED
}
}

template <int EPI>
DI void gemm_phase(const bf16_t* A, int lda, const bf16_t* Bt, int K, int N, bf16_t* O, int ldo, char* smem, const int wid, float* knp = nullptr) {
    pg8::Gemm g; g.A = A; g.Bt = Bt; g.lda = lda; g.N = N; g.K = K;
    pg8::StaticOrder S; S.init(NTOK, N, gridDim.x, blockIdx.x);
    pg8::Epi<EPI> E; E.O = O; E.ldo = ldo; E.kn = knp; E.xch = (float*)(smem + 131072);
    pg8::gemm_phase(( LDS3 unsigned char*)smem, g, S, E, wid);
    __syncthreads();
}

DI void corr_phase(const Params& p, char* smem, const int wid) {
    pg8::Gemm g; g.A = p.P; g.Bt = RET_ST(p); g.lda = LD1; g.N = 512; g.K = 256;
    pg8::CorrOrder S; S.G = gridDim.x; S.c = blockIdx.x;
    pg8::CorrEpi E; E.C01 = RET_C01(p); E.C23 = RET_C23(p);
    pg8::gemm_phase((LDS3 unsigned char*)smem, g, S, E, wid);
    __syncthreads();
}

constexpr int KST = 272, VST = 320;
DI void attn_phase(const Params& p, char* smem, bf16_t* ybase, int ldy, const int wid) {
    const int tid = TIDX, w = wid, lane = tid & 63, l31 = lane & 31, hh = lane >> 5;
    const int rg = w >> 1, c = w & 1;
    const int pi = (l31 & 0x13) | ((l31 & 4) << 1) | ((l31 & 8) >> 1);
    const int q4 = (lane & 15) >> 2, p2 = lane & 3, blk = (lane >> 4) & 1;
    char* Kb = smem;
    char* Vb = smem + 3 * 64 * KST;
    float* X = (float*)smem + rg * (128 * 32);
    float* KM = (float*)(smem + 3 * 64 * KST + 3 * 64 * VST);
    float d1 = 0.f, d2 = 0.f;
    for (int i = 0; i < 64; ++i) { d1 += p.lq1[i] * p.lk1[i]; d2 += p.lq2[i] * p.lk2[i]; }
    const float lam_init = 0.2f;
    const float lam = __expf(d1) - __expf(d2) + lam_init;
    unsigned* ctr = (unsigned*)(p.mod + 24576 + 8192);
    int* sitem = (int*)(smem + 3 * 64 * KST + 3 * 64 * VST + 1024);
    unsigned* vflag = (unsigned*)(smem + 3 * 64 * KST + 3 * 64 * VST + 1024 + 64);
    for (;;) {
        if (tid == 0) *sitem = (int)atomicAdd(&ctr[0], 1u);
        __syncthreads();
        const int idx = __builtin_amdgcn_readfirstlane(*sitem);
        if (idx >= 2048) break;
        const int qb = 63 - (idx >> 5), bh = idx & 31, b = bh >> 3, h = bh & 7;
        const float slope2 = exp2f(-(float)(h + 1)) * LOG2E;
        bf16x8 qbias;
        {
            const float shi = bflo(pk2(slope2, 0.f));
            u32x4 qb = {0u, 0u, 0u, 0u};
            qb.x = hh == 0 ? pk2(shi, slope2 - shi) : 0u;
            qbias = __builtin_bit_cast(bf16x8, qb);
        }
        const int qpos = qb * 128 + rg * 32 + l31;
        const size_t tq = (size_t)b * SEQ + qpos;
        bf16x8 qf[4];
        {
            const bf16_t* qp = p.P + tq * LD0 + h * 128 + c * 64 + 8 * hh;
#pragma unroll
            for (int s = 0; s < 4; ++s) qf[s] = *(const bf16x8*)(qp + 16 * s);
        }
        const int mytile = 2 * qb + (rg >> 1);
        const int jmax = 2 * qb + 1;
        const int lrow = tid >> 4, lch = tid & 15;
        const bf16_t* kg = p.P + (size_t)NTOK * LD0 + (((size_t)b * 8 + h) * SEQ + lrow) * 256 + lch * 8;
        u32x4 rkA[2], rvA[2], t0k[2], t0v[2], t1k[2], t1v[2];
        {
            const int j2 = jmax >= 2 ? jmax - 2 : 0;
#pragma unroll
            for (int i = 0; i < 2; ++i) {
                const bf16_t* s0 = kg + (size_t)(jmax * 64 + 32 * i) * 256;
                const bf16_t* s1 = kg + (size_t)((jmax - 1) * 64 + 32 * i) * 256;
                const bf16_t* s2 = kg + (size_t)(j2 * 64 + 32 * i) * 256;
                t0k[i] = *(const u32x4*)s0; t0v[i] = *(const u32x4*)(s0 + 128);
                t1k[i] = *(const u32x4*)s1; t1v[i] = *(const u32x4*)(s1 + 128);
                rkA[i] = *(const u32x4*)s2; rvA[i] = *(const u32x4*)(s2 + 128);
            }
        }
        float kv0 = 0.f, kv1 = 0.f;
        if (w < 2) { const float* knp = p.mod + 24576 + ((b * 8 + h) * 2 + w) * 128; kv0 = knp[2 * lane]; kv1 = knp[2 * lane + 1]; }
        float qn;
        {
            float sq = 0.f;
#pragma unroll
            for (int s4 = 0; s4 < 4; ++s4) {
                const u32x4 u = __builtin_bit_cast(u32x4, qf[s4]);
#pragma unroll
                for (int j = 0; j < 4; ++j) sq += bflo(u[j]) * bflo(u[j]) + bfhi(u[j]) * bfhi(u[j]);
            }
            sq += __shfl_xor(sq, 32);
            qn = sqrtf(sq) * 1.001f;
        }
        if (w < 2) {
            const float v0 = kv0, v1 = kv1;
            float incl = fmaxf(v0, v1);
#pragma unroll
            for (int o = 1; o < 64; o <<= 1) { const float t = __shfl_up(incl, o); if (lane >= o) incl = fmaxf(incl, t); }
            float excl = __shfl_up(incl, 1); if (lane == 0) excl = 0.f;
            KM[w * 128 + 2 * lane] = sqrtf(fmaxf(excl, v0)) * 1.001f;
            KM[w * 128 + 2 * lane + 1] = sqrtf(incl) * 1.001f;
        }
        int wdone = 0;
        f32x16 O[4];
#pragma unroll
        for (int et = 0; et < 4; ++et)
#pragma unroll
            for (int r = 0; r < 16; ++r) O[et][r] = 0.f;
        float m = -1e30f, l = 0.f;
#pragma unroll
        for (int i = 0; i < 2; ++i) {
            *(u32x4*)(Kb + (lrow + 32 * i) * KST + lch * 16) = t0k[i];
            *(u32x4*)(Vb + (lrow + 32 * i) * VST + lch * 16) = t0v[i];
            *(u32x4*)(Kb + 64 * KST + (lrow + 32 * i) * KST + lch * 16) = t1k[i];
            *(u32x4*)(Vb + 64 * VST + (lrow + 32 * i) * VST + lch * 16) = t1v[i];
        }
        if (tid < 4) vflag[8 + 4 + tid] = 0u;
        __syncthreads();
        bf16x8 pf[2][2];
        bool havep = false;
        const bool grpA = w < 4;
        auto QS = [&](const int jt, const int buf) __attribute__((always_inline)) {
            if (jt <= mytile && !wdone) {
                const char* kb = Kb + buf * 64 * KST;
                f32x16 S[2];
#pragma unroll
                for (int kt = 0; kt < 2; ++kt) {
#pragma unroll
                    for (int r = 0; r < 16; ++r) S[kt][r] = 0.f;
                    {
                        u32x4 kbu = {0u, 0u, 0u, 0u};
                        const float kl = (float)(32 * kt + pi);
                        kbu.x = hh == 0 ? pk2(kl, kl) : 0u;
                        S[kt] = __builtin_amdgcn_mfma_f32_32x32x16_bf16(__builtin_bit_cast(bf16x8, kbu), qbias, S[kt], 0, 0, 0);
                    }
#pragma unroll
                    for (int s4 = 0; s4 < 4; ++s4) {
                        const bf16x8 kf = *(const bf16x8*)(kb + (32 * kt + pi) * KST + (c * 64 + 16 * s4 + 8 * hh) * 2);
                        S[kt] = __builtin_amdgcn_mfma_f32_32x32x16_bf16(kf, qf[s4], S[kt], 0, 0, 0);
                    }
                }
                const int dqi = qpos - jt * 64;
                if (jt == mytile) {
#pragma unroll
                    for (int kt = 0; kt < 2; ++kt)
#pragma unroll
                        for (int r = 0; r < 16; ++r) {
                            const int kloc = 32 * kt + (r & 3) + 4 * ((r >> 2) & 1) + 16 * (r >> 3) + 8 * hh;
                            S[kt][r] -= 2.f * slope2 * fmaxf((float)(kloc - dqi), 0.f);
                        }
                }
                const float u = slope2 * (float)dqi;
                float mt = -1e30f;
#pragma unroll
                for (int kt = 0; kt < 2; ++kt)
#pragma unroll
                    for (int r = 0; r < 16; ++r) mt = fmaxf(mt, S[kt][r]);
                mt -= u;
                mt = fmaxf(mt, __shfl_xor(mt, 32));
                const float mnew = fmaxf(m, mt);
                if (__any(mnew > m)) {
                    const float alpha = __builtin_amdgcn_exp2f(m - mnew);
                    l *= alpha;
#pragma unroll
                    for (int et = 0; et < 4; ++et)
#pragma unroll
                        for (int r = 0; r < 16; ++r) O[et][r] *= alpha;
                }
                m = mnew;
                const float Mt = m + u;
                const f32x2 Mt2 = {Mt, Mt};
                f32x2 l2 = {0.f, 0.f};
#pragma unroll
                for (int kt = 0; kt < 2; ++kt)
#pragma unroll
                    for (int s2 = 0; s2 < 2; ++s2) {
                        u32x4 uu;
#pragma unroll
                        for (int j = 0; j < 8; j += 2) {
                            const f32x2 x = (f32x2){S[kt][8 * s2 + j], S[kt][8 * s2 + j + 1]} - Mt2;
                            f32x2 e2; e2.x = __builtin_amdgcn_exp2f(x.x); e2.y = __builtin_amdgcn_exp2f(x.y);
                            l2 = l2 + e2;
                            uu[j >> 1] = pk2(e2.x, e2.y);
                        }
                        pf[kt][s2] = __builtin_bit_cast(bf16x8, uu);
                    }
                l += l2.x + l2.y;
                if (jt > 0) {
                    const float bound = qn * KM[c * 128 + jt - 1] + 1.0f - slope2 * (float)(qpos - (64 * (jt - 1) + 63));
                    wdone = __all(bound < m - 160.f);
                }
                havep = true;
            }
        };
        auto PV = [&](const int buf) __attribute__((always_inline)) {
            if (havep) {
                const char* vb = Vb + buf * 64 * VST;
#pragma unroll
                for (int kt = 0; kt < 2; ++kt)
#pragma unroll
                    for (int s2 = 0; s2 < 2; ++s2)
#pragma unroll
                        for (int et = 0; et < 4; ++et) {
                            const char* va = vb + (32 * kt + 16 * s2 + 8 * hh + q4) * VST + (32 * et + 16 * blk + 4 * p2) * 2;
                            const bf16x8 vf = cat4(tr_read(va), tr_read(va + 4 * VST));
                            O[et] = __builtin_amdgcn_mfma_f32_32x32x16_bf16(vf, pf[kt][s2], O[et], 0, 0, 0);
                        }
                havep = false;
            }
        };
        auto STAGE = [&](const int jt, const int dst, u32x4 (&rk)[2], u32x4 (&rv)[2]) __attribute__((always_inline)) {
            char* kd = Kb + dst * 64 * KST;
            char* vd = Vb + dst * 64 * VST;
#pragma unroll
            for (int i = 0; i < 2; ++i) {
                *(u32x4*)(kd + (lrow + 32 * i) * KST + lch * 16) = rk[i];
                *(u32x4*)(vd + (lrow + 32 * i) * VST + lch * 16) = rv[i];
            }
            const int j3 = jt >= 3 ? jt - 3 : 0;
#pragma unroll
            for (int i = 0; i < 2; ++i) {
                const bf16_t* src = kg + (size_t)(j3 * 64 + 32 * i) * 256;
                rk[i] = *(const u32x4*)src; rv[i] = *(const u32x4*)(src + 128);
            }
        };
        auto VOTE = [&](const int ps) __attribute__((always_inline)) -> bool {
            if (lane == 0) vflag[(grpA ? 0 : 8) + ps * 4 + (w & 3)] = wdone;
            __syncthreads();
            const u32x4 fa = *(const u32x4*)(vflag + ps * 4), fb = *(const u32x4*)(vflag + 8 + (ps ^ 1) * 4);
            return (fa.x & fa.y & fa.z & fa.w & fb.x & fb.y & fb.z & fb.w) != 0u;
        };
        if (!grpA) __syncthreads();
        {
            int buf = 0, dst = 2;
            for (int jt = jmax; jt >= 0; --jt) {
                QS(jt, buf);
                __syncthreads();
                PV(buf);
                STAGE(jt, dst, rkA, rvA);
                const bool alldone = VOTE((jmax - jt) & 1);
                buf = buf == 2 ? 0 : buf + 1; dst = dst == 2 ? 0 : dst + 1;
                if (alldone) break;
            }
        }
        if (grpA) __syncthreads();
        const float lt = l + __shfl_xor(l, 32);
        const float inv = 1.f / lt;
        if (c == 1) {
            const float f = lam * inv;
#pragma unroll
            for (int et = 0; et < 4; ++et)
#pragma unroll
                for (int r = 0; r < 16; ++r) {
                    const int e = 32 * et + (r & 3) + 8 * (r >> 2) + 4 * hh;
                    X[e * 32 + l31] = O[et][r] * f;
                }
        }
        __syncthreads();
        if (c == 0) {
            float ss = 0.f;
#pragma unroll
            for (int et = 0; et < 4; ++et)
#pragma unroll
                for (int r = 0; r < 16; ++r) {
                    const int e = 32 * et + (r & 3) + 8 * (r >> 2) + 4 * hh;
                    const float o = O[et][r] * inv - X[e * 32 + l31];
                    O[et][r] = o; ss += o * o;
                }
            ss += __shfl_xor(ss, 32);
            const float rstd = rsqrtf(ss * (1.f / 128.f) + 1e-5f) * (1.f - lam_init);
            bf16_t* gp = p.P + tq * LD0 + 3072 + h * 128;
#pragma unroll
            for (int et = 0; et < 4; ++et)
#pragma unroll
                for (int g4 = 0; g4 < 4; ++g4) {
                    const int e0 = 32 * et + 8 * g4 + 4 * hh;
                    const u32x2 gv = *(const u32x2*)(gp + e0);
                    const f32x4 sg = *(const f32x4*)(p.subln + e0);
                    u32x2 y;
                    y.x = pk2(O[et][4 * g4 + 0] * rstd * sg[0] * silu_f(bflo(gv.x)), O[et][4 * g4 + 1] * rstd * sg[1] * silu_f(bfhi(gv.x)));
                    y.y = pk2(O[et][4 * g4 + 2] * rstd * sg[2] * silu_f(bflo(gv.y)), O[et][4 * g4 + 3] * rstd * sg[3] * silu_f(bfhi(gv.y)));
                    *(u32x2*)(ybase + tq * ldy + h * 128 + e0) = y;
                }
        }
        __syncthreads();
    }
}

constexpr int QST = 528;
DI void retA_phase(const Params& p, char* smem, const int wid) {
    const int tid = TIDX, w = wid, lane = tid & 63, l15 = lane & 15, quad = lane >> 4;
    char* Qs = smem;
    char* Ks = smem + 64 * QST;
    const int qrow = tid >> 5, qch = tid & 31;
    u32x4 rq[4], rk[4];
    if (blockIdx.x < 2048) {
        const int item = blockIdx.x, bh = item >> 7, n = item & 127, b = bh >> 2, h = bh & 3;
        const bf16_t* qg = p.P + ((size_t)b * SEQ + n * 64 + qrow) * LD1 + h * 256 + qch * 8;
#pragma unroll
        for (int i = 0; i < 4; ++i) { rq[i] = *(const u32x4*)(qg + (size_t)(16 * i) * LD1); rk[i] = *(const u32x4*)(qg + (size_t)(16 * i) * LD1 + 1024); }
    }
    for (int item = blockIdx.x; item < 2048; item += gridDim.x) {
        const int bh = item >> 7, h = bh & 3;
        const float lg = __log2f(1.f - exp2f(-5.f - (float)h));
#pragma unroll
        for (int i = 0; i < 4; ++i) { *(u32x4*)(Qs + (qrow + 16 * i) * QST + qch * 16) = rq[i]; *(u32x4*)(Ks + (qrow + 16 * i) * QST + qch * 16) = rk[i]; }
        __syncthreads();
        {
            const int nx = item + (int)gridDim.x < 2048 ? item + (int)gridDim.x : item;
            const int bh2 = nx >> 7, n2 = nx & 127, b2 = bh2 >> 2, h2 = bh2 & 3;
            const bf16_t* qg = p.P + ((size_t)b2 * SEQ + n2 * 64 + qrow) * LD1 + h2 * 256 + qch * 8;
#pragma unroll
            for (int i = 0; i < 4; ++i) { rq[i] = *(const u32x4*)(qg + (size_t)(16 * i) * LD1); rk[i] = *(const u32x4*)(qg + (size_t)(16 * i) * LD1 + 1024); }
        }
        const int ti = w >> 1, tj0 = 2 * (w & 1);
        f32x4 a2[2] = {(f32x4){0.f, 0.f, 0.f, 0.f}, (f32x4){0.f, 0.f, 0.f, 0.f}};
#pragma unroll
        for (int ks = 0; ks < 8; ++ks) {
            const bf16x8 qf = *(const bf16x8*)(Qs + (16 * ti + l15) * QST + (32 * ks + 8 * quad) * 2);
#pragma unroll
            for (int jj = 0; jj < 2; ++jj) {
                const bf16x8 kf = *(const bf16x8*)(Ks + (16 * (tj0 + jj) + l15) * QST + (32 * ks + 8 * quad) * 2);
                a2[jj] = __builtin_amdgcn_mfma_f32_16x16x32_bf16(kf, qf, a2[jj], 0, 0, 0);
            }
        }
        const int i = 16 * ti + l15;
        bf16_t* ag = p.H + (size_t)item * 4096 + i * 64;
#pragma unroll
        for (int jj = 0; jj < 2; ++jj) {
            float v[4];
#pragma unroll
            for (int r = 0; r < 4; ++r) {
                const int j = 16 * (tj0 + jj) + 4 * quad + r;
                const int ad = i > j ? i - j : j - i;
                v[r] = a2[jj][r] * exp2f(lg * (float)(ad + j - 64));
            }
            u32x2 o; o.x = pk2(v[0], v[1]); o.y = pk2(v[2], v[3]);
            *(u32x2*)(ag + 16 * (tj0 + jj) + 4 * quad) = o;
        }
        __syncthreads();
    }
}

constexpr int SQST = 520, SKST = 576, SVST = 192, RST = 65;
DI void scan_phase(const Params& p, char* smem, bf16_t* obase, int ldob, const int wid) {
    const int tid = TIDX, w = wid, lane = tid & 63, l31 = lane & 31, hh = lane >> 5;
    const int q4 = (lane & 15) >> 2, p2 = lane & 3, blk = (lane >> 4) & 1;
    const int dq = w >> 1, eh = w & 1;
    char* Qs = smem;
    char* Ks = smem + 64 * SQST;
    char* Vs = Ks + 64 * SKST;
    float* Red = (float*)(Vs + 64 * SVST);
    for (int item2 = blockIdx.x; item2 < 256; item2 += gridDim.x) {
        const int hf = item2 >> 7, item = item2 & 127, c0n = 64 * hf;
        const int bh = item >> 3, sl = item & 7, b = bh >> 2, h = bh & 3;
        const float lg = __log2f(1.f - exp2f(-5.f - (float)h));
        const float cd = exp2f(64.f * lg);
        const float gi0 = exp2f(lg * (float)l31), gi1 = exp2f(lg * (float)(32 + l31));
        f32x16 st[2];
#pragma unroll
        for (int dt = 0; dt < 2; ++dt)
#pragma unroll
            for (int r = 0; r < 16; ++r) st[dt][r] = 0.f;
        const bf16_t* base = p.P + ((size_t)b * SEQ + c0n * 64) * LD1;
        const int qrow = tid >> 5, qch = tid & 31, vrow = tid >> 3, vch = tid & 7;
        const bf16_t* qg = base + (size_t)qrow * LD1 + h * 256 + qch * 8;
        const bf16_t* vg = base + (size_t)vrow * LD1 + 2048 + h * 512 + sl * 64 + vch * 8;
        const bf16_t* agp = p.H + ((size_t)bh * 128 + c0n) * 4096 + l31 * 64 + 16 * dq + 8 * hh;
        u32x4 rqX[4], rkX[4], rvX, raA[2], raB[2];
#pragma unroll
        for (int i = 0; i < 4; ++i) { rqX[i] = *(const u32x4*)(qg + (size_t)(16 * i) * LD1); rkX[i] = *(const u32x4*)(qg + (size_t)(16 * i) * LD1 + 1024); }
        rvX = *(const u32x4*)vg;
#pragma unroll
        for (int i = 0; i < 4; ++i) {
            char* qd = Qs + (qrow + 16 * i) * SQST + qch * 16;
            *(u32x2*)qd = (u32x2){rqX[i].x, rqX[i].y}; *(u32x2*)(qd + 8) = (u32x2){rqX[i].z, rqX[i].w};
            *(u32x4*)(Ks + (qrow + 16 * i) * SKST + qch * 16) = rkX[i];
        }
        *(u32x4*)(Vs + vrow * SVST + vch * 16) = rvX;
        raA[0] = *(const u32x4*)agp; raA[1] = *(const u32x4*)(agp + 32 * 64);
        {
            const size_t r1 = (size_t)64 * LD1;
#pragma unroll
            for (int i = 0; i < 4; ++i) { rqX[i] = *(const u32x4*)(qg + r1 + (size_t)(16 * i) * LD1); rkX[i] = *(const u32x4*)(qg + r1 + (size_t)(16 * i) * LD1 + 1024); }
            rvX = *(const u32x4*)(vg + r1);
        }
        __syncthreads();
        auto step = [&](const int n, u32x4 (&ra)[2], u32x4 (&ran)[2], u32x4 (&rq)[4], u32x4 (&rk)[4], u32x4& rv) __attribute__((always_inline)) {
            {
                const int n1 = n + 1 < 64 ? n + 1 : 63;
                ran[0] = *(const u32x4*)(agp + (size_t)n1 * 4096); ran[1] = *(const u32x4*)(agp + (size_t)n1 * 4096 + 32 * 64);
            }
            f32x16 part[2];
#pragma unroll
            for (int it = 0; it < 2; ++it)
#pragma unroll
                for (int r = 0; r < 16; ++r) part[it][r] = 0.f;
#pragma unroll
            for (int dt = 0; dt < 2; ++dt)
#pragma unroll
                for (int s2 = 0; s2 < 2; ++s2) {
                    u32x4 su;
                    su.x = pk2(st[dt][8 * s2 + 0], st[dt][8 * s2 + 1]); su.y = pk2(st[dt][8 * s2 + 2], st[dt][8 * s2 + 3]);
                    su.z = pk2(st[dt][8 * s2 + 4], st[dt][8 * s2 + 5]); su.w = pk2(st[dt][8 * s2 + 6], st[dt][8 * s2 + 7]);
                    const bf16x8 sf = __builtin_bit_cast(bf16x8, su);
#pragma unroll
                    for (int it = 0; it < 2; ++it) {
                        const char* qa = Qs + (32 * it + l31) * SQST + (64 * dq + 32 * dt + 16 * s2 + 4 * hh) * 2;
                        const bf16x8 qf = cat4(*(const s16x4*)qa, *(const s16x4*)(qa + 16));
                        part[it] = __builtin_amdgcn_mfma_f32_32x32x16_bf16(sf, qf, part[it], 0, 0, 0);
                    }
                }
#pragma unroll
            for (int r = 0; r < 16; ++r) { part[0][r] *= gi0; part[1][r] *= gi1; }
            bf16x8 vfr[4];
            const char* vb = Vs + (8 * hh + q4) * SVST + (32 * eh + 16 * blk + 4 * p2) * 2;
#pragma unroll
            for (int ks = 0; ks < 4; ++ks) vfr[ks] = cat4(tr_read(vb + 16 * ks * SVST), tr_read(vb + (16 * ks + 4) * SVST));
            {
                const bf16x8 vsel = cat4(tr_read(vb + 16 * dq * SVST), tr_read(vb + (16 * dq + 4) * SVST));
#pragma unroll
                for (int it = 0; it < 2; ++it) part[it] = __builtin_amdgcn_mfma_f32_32x32x16_bf16(vsel, __builtin_bit_cast(bf16x8, ra[it]), part[it], 0, 0, 0);
            }
#pragma unroll
            for (int it = 0; it < 2; ++it)
#pragma unroll
                for (int r = 0; r < 16; ++r) {
                    const int e = 32 * eh + (r & 3) + 8 * (r >> 2) + 4 * hh;
                    Red[(dq * 64 + 32 * it + l31) * RST + e] = part[it][r];
                }
#pragma unroll
            for (int dt = 0; dt < 2; ++dt) {
                const char* kb = Ks + (8 * hh + q4) * SKST + (64 * dq + 32 * dt + 16 * blk + 4 * p2) * 2;
#pragma unroll
                for (int r = 0; r < 16; ++r) st[dt][r] *= cd;
#pragma unroll
                for (int ks = 0; ks < 4; ++ks) {
                    const bf16x8 kf = cat4(tr_read(kb + 16 * ks * SKST), tr_read(kb + (16 * ks + 4) * SKST));
                    st[dt] = __builtin_amdgcn_mfma_f32_32x32x16_bf16(kf, vfr[ks], st[dt], 0, 0, 0);
                }
            }
            __syncthreads();
            {
#pragma unroll
                for (int i = 0; i < 4; ++i) {
                    char* qd = Qs + (qrow + 16 * i) * SQST + qch * 16;
                    *(u32x2*)qd = (u32x2){rq[i].x, rq[i].y}; *(u32x2*)(qd + 8) = (u32x2){rq[i].z, rq[i].w};
                    *(u32x4*)(Ks + (qrow + 16 * i) * SKST + qch * 16) = rk[i];
                }
                *(u32x4*)(Vs + vrow * SVST + vch * 16) = rv;
                const int n3 = n + 2 < 64 ? n + 2 : 63;
                const size_t ro = (size_t)n3 * 64 * LD1;
#pragma unroll
                for (int i = 0; i < 4; ++i) { rq[i] = *(const u32x4*)(qg + ro + (size_t)(16 * i) * LD1); rk[i] = *(const u32x4*)(qg + ro + (size_t)(16 * i) * LD1 + 1024); }
                rv = *(const u32x4*)(vg + ro);
            }
            {
                const int i = tid >> 3, eg = tid & 7;
                float v[8];
#pragma unroll
                for (int ee = 0; ee < 8; ++ee) {
                    float sacc = 0.f;
#pragma unroll
                    for (int d4 = 0; d4 < 4; ++d4) sacc += Red[(d4 * 64 + i) * RST + 8 * eg + ee];
                    v[ee] = sacc;
                }
                u32x4 o; o.x = pk2(v[0], v[1]); o.y = pk2(v[2], v[3]); o.z = pk2(v[4], v[5]); o.w = pk2(v[6], v[7]);
                bf16_t* og = obase + ((size_t)b * SEQ + (c0n + n) * 64 + i) * ldob + h * 512 + sl * 64 + 8 * eg;
                *(u32x4*)og = o;
            }
            __syncthreads();
        };
        for (int n = 0; n < 64; n += 2) {
            step(n, raA, raB, rqX, rkX, rvX);
            step(n + 1, raB, raA, rqX, rkX, rvX);
        }
        if (hf == 0) {
            bf16_t* sg = RET_ST(p) + ((size_t)bh * 512 + sl * 64 + 32 * eh + l31) * 256 + 64 * dq + 4 * hh;
#pragma unroll
            for (int dt = 0; dt < 2; ++dt)
#pragma unroll
                for (int g4 = 0; g4 < 4; ++g4) {
                    u32x2 o; o.x = pk2(st[dt][4 * g4 + 0], st[dt][4 * g4 + 1]); o.y = pk2(st[dt][4 * g4 + 2], st[dt][4 * g4 + 3]);
                    *(u32x2*)(sg + 32 * dt + 8 * g4) = o;
                }
        }
    }
}

DI void grid_barrier(unsigned* ctr, const unsigned target, const int wid) {
    asm volatile("s_waitcnt vmcnt(0)" ::: "memory");
    __syncthreads();
    if (wid == 0 && lane_id() == 0) {
        __builtin_amdgcn_fence(__ATOMIC_RELEASE, "agent");
        asm volatile("s_waitcnt vmcnt(0)" ::: "memory");
        __hip_atomic_fetch_add(ctr, 1u, __ATOMIC_RELAXED, __HIP_MEMORY_SCOPE_AGENT);
        while (__hip_atomic_load(ctr, __ATOMIC_RELAXED, __HIP_MEMORY_SCOPE_AGENT) < target) __builtin_amdgcn_s_sleep(1);
        __builtin_amdgcn_fence(__ATOMIC_ACQUIRE, "agent");
        asm volatile("s_waitcnt vmcnt(0)" ::: "memory");
    }
    __syncthreads();
}

__global__ void __launch_bounds__(NT) mega(Params p) {
    extern __shared__ __attribute__((aligned(16))) char smem[];
    cg::grid_group grid = cg::this_grid();
    const int wid = __builtin_amdgcn_readfirstlane(threadIdx.x >> 6);
    unsigned* const gbar = (unsigned*)(p.mod + 34816);
    unsigned nbar = 0;
#define GSYNC() do { if (nbar == 0) grid.sync(); else grid_barrier(gbar, nbar * gridDim.x, wid); ++nbar; } while (0)
#define PSYNC() GSYNC()
    prep_phase(p, smem, wid);
    norm0_phase(p, wid);
    PSYNC();
    gemm_phase<0>(p.H, DM, p.Wt0in, 1024, 4096, p.P, LD0, smem, wid, p.mod + 24576);
    PSYNC();
    attn_phase(p, smem, p.P + 3072, LD0, wid);
    PSYNC();
    gemm_phase<2>(p.P + 3072, LD0, p.Wt0out, 1024, 1024, p.P, LD0, smem, wid);
    PSYNC();
    post_phase<0>(p, LD0, wid);
    PSYNC();
    gemm_phase<1>(p.H, DM, p.Wt1in, 1024, 6144, p.P, LD1, smem, wid);
    PSYNC();
    retA_phase(p, smem, wid);
    PSYNC();
    scan_phase(p, smem, p.P + 2048, LD1, wid);
    PSYNC();
    if (blockIdx.x & 1) gate1_phase(p, wid, 0);
    corr_phase(p, smem, wid);
    if (!(blockIdx.x & 1)) gate1_phase(p, wid, 0);
    PSYNC();
    gate1_phase(p, wid, 1);
    PSYNC();
    gemm_phase<2>(p.P + 4096, LD1, p.Wt1out, 2048, 1024, p.P, LD1, smem, wid);
    PSYNC();
    post_phase<1>(p, LD1, wid);
}

extern "C" void kernel_launch(void* const* d_in, const int* in_sizes, int n_in, void* d_out, int out_size, void* d_ws, size_t ws_size, hipStream_t stream) {
    static int grid_blocks = 0;
    if (!grid_blocks) {
        hipFuncSetAttribute((const void*)mega, hipFuncAttributeMaxDynamicSharedMemorySize, SMEM_BYTES);
        int dev = 0, cus = 0, per_cu = 0;
        hipGetDevice(&dev);
        hipDeviceGetAttribute(&cus, hipDeviceAttributeMultiprocessorCount, dev);
        hipOccupancyMaxActiveBlocksPerMultiprocessor(&per_cu, mega, NT, SMEM_BYTES);
        if (per_cu < 1) per_cu = 1;
        if (per_cu > 1) per_cu = 1;
        grid_blocks = cus * per_cu;
    }
    Params p{};
    p.x = (const float*)d_in[0]; p.c = (const float*)d_in[1]; p.ada_w = (const float*)d_in[2]; p.ada_b = (const float*)d_in[3];
    p.pre_gain = (const float*)d_in[4]; p.post_gain = (const float*)d_in[5]; p.da_w_in = (const float*)d_in[6]; p.da_w_out = (const float*)d_in[7];
    p.lq1 = (const float*)d_in[8]; p.lk1 = (const float*)d_in[9]; p.lq2 = (const float*)d_in[10]; p.lk2 = (const float*)d_in[11];
    p.subln = (const float*)d_in[12]; p.ret_w_in = (const float*)d_in[13]; p.ret_w_out = (const float*)d_in[14];
    p.out = (float*)d_out;
    char* ws = (char*)d_ws;
    p.Wt0in = (bf16_t*)(ws + 0);
    p.Wt0out = (bf16_t*)(ws + 8388608);
    p.Wt1in = (bf16_t*)(ws + 10485760);
    p.Wt1out = (bf16_t*)(ws + 23068672);
    p.mod = (float*)(ws + 27262976);
    p.H = (bf16_t*)(ws + 27525120);
    p.P = (bf16_t*)(ws + 94633984);
    hipMemsetAsync((char*)d_ws + 27262976 + 131072, 0, 16384, stream);
    void* args[] = {&p};
    hipError_t e = hipLaunchCooperativeKernel((void*)mega, dim3(grid_blocks), dim3(NT), args, SMEM_BYTES, stream);
    if (e != hipSuccess) fprintf(stderr, "cooperative launch failed: %s (grid %d)\n", hipGetErrorString(e), grid_blocks);
}
```
